# Optimizing an MI355X kernel written in HIP

```python
import math
import jax, jax.numpy as jnp
from jax import lax
import numpy as np

D_MODEL = 1024
BATCH = 8
SEQ = 2048
DEPTH = 1

HEAD_DIM = 128
DN_HEADS = D_MODEL // 256
DN_WIDTH = DN_HEADS * HEAD_DIM
CONV_WIDTH = 4
CHUNK = 64
SWA_GROUPS = ((128, 1), (512, 4), (2048, 16))
N_GROUPS = 3
SWA_HEADS = D_MODEL // 256
SWA_WIDTH = SWA_HEADS * HEAD_DIM
ROPE_DIM = HEAD_DIM // 4
ROPE_THETA = 500000.0
N_BRANCHES = 2
EPS = 1e-6
NEG_INF = -1e30

IN_SIZES = (3 * DN_WIDTH, DN_WIDTH, DN_HEADS, DN_HEADS,
            N_GROUPS * SWA_WIDTH, N_GROUPS * SWA_WIDTH, N_GROUPS * SWA_WIDTH, SWA_WIDTH,
            N_BRANCHES * D_MODEL)
IN_COLS = sum(IN_SIZES)

kernel_name = "hybrid_gated_deltanet_dilated_swa_block"


def rms_norm(x, w):
    xf = x.astype(jnp.float32)
    y = xf * lax.rsqrt(jnp.mean(xf * xf, axis=-1, keepdims=True) + EPS)
    return y.astype(x.dtype) * w.astype(x.dtype)


def l2_normalize(x):
    return x * lax.rsqrt(jnp.sum(x * x, axis=-1, keepdims=True) + EPS)


def causal_depthwise_conv(x, w):
    c = x.shape[-1]
    return lax.conv_general_dilated(x, w.astype(x.dtype), window_strides=(1,), padding=[(CONV_WIDTH - 1, 0)],
                                    dimension_numbers=('NWC', 'WIO', 'NWC'), feature_group_count=c)


def partial_rope(x, cos, sin):
    half = ROPE_DIM // 2
    x1, x2, xp = x[..., :half], x[..., half:ROPE_DIM], x[..., ROPE_DIM:]
    c = cos[:, None, None, :].astype(x.dtype)
    s = sin[:, None, None, :].astype(x.dtype)
    return jnp.concatenate([x1 * c - x2 * s, x2 * c + x1 * s, xp], axis=-1)


def gated_delta_rule_chunked(q, k, v, g, beta):
    B, H, T, Dk = q.shape
    Dv = v.shape[-1]
    N = T // CHUNK
    q = q.reshape(B, H, N, CHUNK, Dk)
    k = k.reshape(B, H, N, CHUNK, Dk)
    v = v.reshape(B, H, N, CHUNK, Dv)
    g = g.reshape(B, H, N, CHUNK)
    beta = beta.reshape(B, H, N, CHUNK)
    gc = jnp.cumsum(g, axis=-1)
    idx = jnp.arange(CHUNK)
    causal = idx[:, None] >= idx[None, :]
    strict = idx[:, None] > idx[None, :]
    decay = jnp.exp(jnp.where(causal, gc[..., :, None] - gc[..., None, :], -jnp.inf))
    kb = k * beta[..., None]
    lower = jnp.where(strict, jnp.einsum('bhnid,bhnjd->bhnij', kb, k) * decay, 0.0)
    eye = jnp.eye(CHUNK, dtype=q.dtype)
    tmat = lax.linalg.triangular_solve(eye + lower, jnp.broadcast_to(eye, lower.shape),
                                       left_side=True, lower=True, unit_diagonal=True)
    u = jnp.einsum('bhnij,bhnjd->bhnid', tmat, v * beta[..., None])
    w = jnp.einsum('bhnij,bhnjd->bhnid', tmat, kb * jnp.exp(gc)[..., None])
    a_intra = jnp.where(causal, jnp.einsum('bhnid,bhnjd->bhnij', q, k) * decay, 0.0)

    def step(S, inp):
        qi, ki, ui, wi, ai, gci = inp
        v_new = ui - jnp.einsum('bhck,bhkv->bhcv', wi, S)
        o = jnp.einsum('bhck,bhkv->bhcv', qi * jnp.exp(gci)[..., None], S) + jnp.einsum('bhij,bhjv->bhiv', ai, v_new)
        glast = gci[..., -1]
        S = S * jnp.exp(glast)[..., None, None] + jnp.einsum(
            'bhck,bhcv->bhkv', ki * jnp.exp(glast[..., None] - gci)[..., None], v_new)
        return S, o

    xs = tuple(jnp.moveaxis(a, 2, 0) for a in (q, k, u, w, a_intra, gc))
    s0 = jnp.zeros((B, H, Dk, Dv), q.dtype)
    _, o = lax.scan(step, s0, xs)
    return jnp.moveaxis(o, 0, 2).reshape(B, H, T, Dv)


def dilated_window_attention(q, k, v, window, dilation):
    B, T, H, Dh = q.shape
    L = T // dilation
    blk = window // dilation
    nb = -(-L // blk)
    Lp = nb * blk

    def to_sub(x):
        x = x.astype(jnp.float32).reshape(B, L, dilation, H, Dh).transpose(0, 2, 3, 1, 4)
        return jnp.pad(x, ((0, 0), (0, 0), (0, 0), (0, Lp - L), (0, 0)))

    def windows(x):
        xp = jnp.pad(x, ((0, 0), (0, 0), (0, 0), (blk, 0), (0, 0))).reshape(B, dilation, H, nb + 1, blk, Dh)
        return jnp.concatenate([xp[:, :, :, :-1], xp[:, :, :, 1:]], axis=4)

    qb = to_sub(q).reshape(B, dilation, H, nb, blk, Dh)
    kw = windows(to_sub(k))
    vw = windows(to_sub(v))
    s = jnp.einsum('brhnqd,brhnkd->brhnqk', qb, kw) * (Dh ** -0.5)
    i = jnp.arange(blk)[:, None]
    j = jnp.arange(2 * blk)[None, :]
    dist = blk + i - j
    key_pos = (jnp.arange(nb)[:, None, None] - 1) * blk + j[None]
    valid = (dist >= 0)[None] & (dist <= blk)[None] & (key_pos >= 0)
    s = jnp.where(valid, s, NEG_INF)
    lse = jax.nn.logsumexp(s, axis=-1)
    p = jnp.exp(s - lse[..., None])
    o = jnp.einsum('brhnqk,brhnkd->brhnqd', p, vw)
    o = o.reshape(B, dilation, H, Lp, Dh)[:, :, :, :L].transpose(0, 3, 1, 2, 4).reshape(B, T, H, Dh)
    lse = lse.reshape(B, dilation, H, Lp)[..., :L].transpose(0, 3, 1, 2).reshape(B, T, H)
    return o, lse


def setup_inputs(seed: int = 0) -> dict:
    key = jax.random.key(seed)
    ks = jax.random.split(key, 13)
    f32 = jnp.float32
    x = jax.random.normal(ks[0], (BATCH, SEQ, D_MODEL), f32)
    norm_w = 1.0 + 0.02 * jax.random.normal(ks[1], (DEPTH, D_MODEL), f32)
    w_in = jax.random.normal(ks[2], (DEPTH, D_MODEL, IN_COLS), f32) * D_MODEL ** -0.5
    conv_w = jax.random.normal(ks[3], (DEPTH, CONV_WIDTH, 1, 3 * DN_WIDTH), f32) * CONV_WIDTH ** -0.5
    dn_a_log = jnp.log(jax.random.uniform(ks[4], (DEPTH, DN_HEADS), f32, 1.0, 16.0))
    dn_dt_bias = 0.1 * jax.random.normal(ks[5], (DEPTH, DN_HEADS), f32)
    dn_norm_w = 1.0 + 0.02 * jax.random.normal(ks[6], (DEPTH, HEAD_DIM), f32)
    q_norm_w = 1.0 + 0.02 * jax.random.normal(ks[7], (DEPTH, N_GROUPS, HEAD_DIM), f32)
    k_norm_w = 1.0 + 0.02 * jax.random.normal(ks[8], (DEPTH, N_GROUPS, HEAD_DIM), f32)
    w_branch_dn = jax.random.normal(ks[9], (DEPTH, DN_WIDTH, D_MODEL), f32) * DN_WIDTH ** -0.5
    w_branch_swa = jax.random.normal(ks[10], (DEPTH, SWA_WIDTH, D_MODEL), f32) * SWA_WIDTH ** -0.5
    w_out = jax.random.normal(ks[11], (DEPTH, D_MODEL, D_MODEL), f32) * D_MODEL ** -0.5
    return {"x": x, "norm_w": norm_w, "w_in": w_in, "conv_w": conv_w, "dn_a_log": dn_a_log,
            "dn_dt_bias": dn_dt_bias, "dn_norm_w": dn_norm_w, "q_norm_w": q_norm_w, "k_norm_w": k_norm_w,
            "w_branch_dn": w_branch_dn, "w_branch_swa": w_branch_swa, "w_out": w_out}


def reference(x, norm_w, w_in, conv_w, dn_a_log, dn_dt_bias, dn_norm_w, q_norm_w, k_norm_w,
              w_branch_dn, w_branch_swa, w_out):
    B, T, _ = x.shape
    split_points = [int(p) for p in np.cumsum(IN_SIZES)[:-1]]
    pos = jnp.arange(T, dtype=jnp.float32)
    inv_freq = ROPE_THETA ** (-jnp.arange(0, ROPE_DIM, 2, dtype=jnp.float32) / ROPE_DIM)
    ang = pos[:, None] * inv_freq[None, :]
    cos, sin = jnp.cos(ang), jnp.sin(ang)

    for layer in range(DEPTH):
        h = rms_norm(x, norm_w[layer])
        proj = h @ w_in[layer]
        (dn_qkv, dn_z, dn_b, dn_a, swa_q, swa_k, swa_v, swa_z, gates) = jnp.split(proj, split_points, axis=-1)

        qkv = jax.nn.silu(causal_depthwise_conv(dn_qkv, conv_w[layer]))
        dq, dk, dv = jnp.split(qkv.astype(jnp.float32), 3, axis=-1)
        to_heads = lambda t: t.reshape(B, T, DN_HEADS, HEAD_DIM).transpose(0, 2, 1, 3)
        dq = l2_normalize(to_heads(dq)) * (HEAD_DIM ** -0.5)
        dk = l2_normalize(to_heads(dk))
        dv = to_heads(dv)
        beta = jax.nn.sigmoid(dn_b.astype(jnp.float32)).transpose(0, 2, 1)
        g = (-jnp.exp(dn_a_log[layer].astype(jnp.float32))
             * jax.nn.softplus(dn_a.astype(jnp.float32) + dn_dt_bias[layer].astype(jnp.float32))).transpose(0, 2, 1)
        o_dn = gated_delta_rule_chunked(dq, dk, dv, g, beta).transpose(0, 2, 1, 3).astype(x.dtype)
        o_dn = rms_norm(o_dn, dn_norm_w[layer]) * jax.nn.silu(dn_z.reshape(B, T, DN_HEADS, HEAD_DIM))
        y_dn = o_dn.reshape(B, T, DN_WIDTH) @ w_branch_dn[layer]

        grp = lambda t: t.reshape(B, T, N_GROUPS, SWA_HEADS, HEAD_DIM)
        sq = partial_rope(rms_norm(grp(swa_q), q_norm_w[layer][:, None, :]), cos, sin)
        sk = partial_rope(rms_norm(grp(swa_k), k_norm_w[layer][:, None, :]), cos, sin)
        sv = grp(swa_v)
        outs, lses = [], []
        for gi, (window, dilation) in enumerate(SWA_GROUPS):
            o_g, lse_g = dilated_window_attention(sq[:, :, gi], sk[:, :, gi], sv[:, :, gi], window, dilation)
            outs.append(o_g)
            lses.append(lse_g)
        alpha = jax.nn.softmax(jnp.stack(lses, axis=0), axis=0)
        o_swa = jnp.sum(alpha[..., None] * jnp.stack(outs, axis=0), axis=0).astype(x.dtype)
        o_swa = o_swa * jax.nn.silu(swa_z.reshape(B, T, SWA_HEADS, HEAD_DIM))
        y_swa = o_swa.reshape(B, T, SWA_WIDTH) @ w_branch_swa[layer]

        g_dn, g_swa = jnp.split(gates, 2, axis=-1)
        merged = jax.nn.sigmoid(g_dn) * y_dn + jax.nn.sigmoid(g_swa) * y_swa
        x = x + merged @ w_out[layer]
    return x
```

```cpp
#include <hip/hip_runtime.h>
#include <cstdio>
#include <cstdint>
namespace pg8 {
#define PG8_LAS __attribute__((address_space(3)))
typedef unsigned short bf16_t;
typedef short bf16x8 __attribute__((ext_vector_type(8)));
typedef float f32x4 __attribute__((ext_vector_type(4)));
typedef unsigned u32x4 __attribute__((ext_vector_type(4)));
constexpr int BM = 256, BK = 64, HALF = 128, HTB = HALF * BK * 2  , STAGE_BYTES = 8 * HTB, NXCD = 8, WGM = 8;

__host__ __device__ __forceinline__ int lds_byte(int r, int c) { const int st = (r >> 4) * 2 + (c >> 5), rr = r & 15, cc = c & 31, ob = rr * 64 + cc * 2; return st * 1024 + (ob ^ (((ob >> 9) & 1) << 5)); }
__host__ __device__ __forceinline__ void stage_rc(int b, int& R, int& C) { const int st = b / 1024, sb = b % 1024, swz = sb ^ (((sb >> 9) & 1) << 5); R = (st >> 1) * 16 + swz / 64; C = (st & 1) * 32 + (swz % 64) / 2; }
__host__ __device__ __forceinline__ int perm32(int rho) { const int n = rho >> 4, i = rho & 15; return 8 * (i >> 2) + 4 * n + (i & 3); }

struct Unit { int pm, pn; };
struct Gemm { const bf16_t* A; const bf16_t* Bt; int M, N, K, lda, ldb; };

struct StaticOrder {
    int nM, nN, nwg, G, c;
    __host__ __device__ void init(int M, int N, int G_, int c_) { nM = M / BM; nN = N / BM; nwg = nM * nN; G = G_; c = c_; }
    __host__ __device__ bool next(int i, Unit& u) const {
        const long L = (long)i * G + c; if (L >= nwg) return false;
        int wgid = (int)L; { const int q = nwg / NXCD, r = nwg % NXCD, xcd = wgid % NXCD, off = wgid / NXCD; wgid = (xcd < r ? xcd * (q + 1) : r * (q + 1) + (xcd - r) * q) + off; }
        const int nig = WGM * nN, gid = wgid / nig, fm = gid * WGM, gsz = (nM - fm) < WGM ? (nM - fm) : WGM;
        u.pm = fm + ((wgid % nig) % gsz); u.pn = (wgid % nig) / gsz; return true;
    }
    __device__ __forceinline__ void a_ready(const Unit&) const {}
    __device__ __forceinline__ void done(const Unit&) const {}
};

__device__ __forceinline__ unsigned cvt_pk_bf16(float lo, float hi) { unsigned r; asm volatile("v_cvt_pk_bf16_f32 %0, %1, %2" : "=v"(r) : "v"(lo), "v"(hi)); return r; }
__device__ __forceinline__ float bf_lo(unsigned w) { return __builtin_bit_cast(float, w << 16); }
__device__ __forceinline__ float bf_hi(unsigned w) { return __builtin_bit_cast(float, w & 0xffff0000u); }
__device__ __forceinline__ float sigmoidf_(float x) { return 1.0f / (1.0f + __expf(-x)); }

template <int MODE> struct EpiBf {
    static constexpr bool PERM = true, AFTER_DRAIN = false;
    bf16_t* O; const bf16_t* S1; const bf16_t* S2; int ldc;
    __device__ __forceinline__ void operator()(const f32x4 (&acc)[2][2][4][2], const Unit& u, int wr, int wc, int fr, int fq) const {
        const int row0 = u.pm * BM + wr * 64 + fr; const int col0 = u.pn * BM + wc * 32 + 8 * fq;
#pragma unroll
        for (int ai = 0; ai < 2; ++ai)
#pragma unroll
            for (int m = 0; m < 4; ++m) { const size_t roff = (size_t)(row0 + ai * HALF + m * 16) * ldc + col0;
#pragma unroll
                for (int bj = 0; bj < 2; ++bj) { f32x4 v0 = acc[ai][bj][m][0], v1 = acc[ai][bj][m][1];
                    if (MODE == 1) {
#pragma unroll
                        for (int e = 0; e < 4; ++e) { v0[e] = sigmoidf_(v0[e]); v1[e] = sigmoidf_(v1[e]); } }
                    if (MODE >= 2) { const u32x4 s = *(const u32x4*)(S1 + roff + bj * HALF);
                        v0[0] *= bf_lo(s.x); v0[1] *= bf_hi(s.x); v0[2] *= bf_lo(s.y); v0[3] *= bf_hi(s.y); v1[0] *= bf_lo(s.z); v1[1] *= bf_hi(s.z); v1[2] *= bf_lo(s.w); v1[3] *= bf_hi(s.w); }
                    if (MODE == 3) { const u32x4 s = *(const u32x4*)(S2 + roff + bj * HALF);
                        v0[0] += bf_lo(s.x); v0[1] += bf_hi(s.x); v0[2] += bf_lo(s.y); v0[3] += bf_hi(s.y); v1[0] += bf_lo(s.z); v1[1] += bf_hi(s.z); v1[2] += bf_lo(s.w); v1[3] += bf_hi(s.w); }
                    u32x4 w; w.x = cvt_pk_bf16(v0[0], v0[1]); w.y = cvt_pk_bf16(v0[2], v0[3]); w.z = cvt_pk_bf16(v1[0], v1[1]); w.w = cvt_pk_bf16(v1[2], v1[3]);
                    *(u32x4*)(O + roff + bj * HALF) = w; } }
    }
};
struct EpiRes {
    static constexpr bool PERM = false, AFTER_DRAIN = false;
    const float* base; float* out; int ldc;
    __device__ __forceinline__ void operator()(const f32x4 (&acc)[2][2][4][2], const Unit& u, int wr, int wc, int fr, int fq) const {
        const int row0 = u.pm * BM + wr * 64 + fr, col0 = u.pn * BM + wc * 32 + 4 * fq;
#pragma unroll
        for (int ai = 0; ai < 2; ++ai)
#pragma unroll
            for (int m = 0; m < 4; ++m) { const size_t roff = (size_t)(row0 + ai * HALF + m * 16) * ldc + col0;
#pragma unroll
                for (int bj = 0; bj < 2; ++bj)
#pragma unroll
                    for (int n = 0; n < 2; ++n) { const f32x4 b = *(const f32x4*)(base + roff + bj * HALF + n * 16); *(f32x4*)(out + roff + bj * HALF + n * 16) = acc[ai][bj][m][n] + b; } }
    }
};

template <class Epi, class Sched, bool ALIGN_EPI = false, bool SP2 = false>
__device__ __forceinline__ void gemm_phase(PG8_LAS unsigned char* lds, const Gemm g, const Sched& S, const Epi& E) {
    const int tid = threadIdx.x, wid = __builtin_amdgcn_readfirstlane(tid >> 6), lane = tid & 63, wr = wid >> 2, wc = wid & 3, fr = lane & 15, fq = lane >> 4;
    const int K = g.K, nt = K / BK;
    unsigned voffA[2], voffB[2];
#pragma unroll
    for (int i = 0; i < 2; ++i) { int R, C; stage_rc(tid * 16 + i * 8192, R, C); const int Rb = Epi::PERM ? ((R & ~31) + perm32(R & 31)) : R;
        voffA[i] = (unsigned)(R * g.lda + C) * 2u; voffB[i] = (unsigned)(Rb * g.ldb + C) * 2u; }
    const size_t kstep = (size_t)(BK * 2);
    const size_t hstepA = (size_t)HALF * g.lda * 2, hstepB = (size_t)HALF * g.ldb * 2;
    const size_t tstepA = 2 * hstepA, tstepB = 2 * hstepB;
    const unsigned ldsw = (unsigned)wid * 1024u;
    const int aoff = lds_byte(wr * 64 + fr, fq * 8), boff = lds_byte(wc * 32 + fr, fq * 8);
#define PG8_SA(b, h) (((b) * 2 + (h)) * HTB)
#define PG8_SB(b, h) ((4 + (b) * 2 + (h)) * HTB)
#define PG8_STAGE(bufoff, gbase, voff) do { _Pragma("unroll") for (int _i = 0; _i < 2; ++_i) \
        __builtin_amdgcn_global_load_lds((const unsigned*)((const char*)(gbase) + (voff)[_i]), (PG8_LAS unsigned*)(lds + (bufoff) + ldsw + _i * 8192), 16, 0, 0); } while (0)
#define PG8_LDA(dst, b, h) do { _Pragma("unroll") for (int m = 0; m < 4; ++m) _Pragma("unroll") for (int k = 0; k < 2; ++k) dst[m][k] = *(const PG8_LAS bf16x8*)(lds + PG8_SA(b, h) + aoff + m * 2048 + k * 1024); } while (0)
#define PG8_LDB(dst, b, h) do { _Pragma("unroll") for (int n = 0; n < 2; ++n) _Pragma("unroll") for (int k = 0; k < 2; ++k) dst[n][k] = *(const PG8_LAS bf16x8*)(lds + PG8_SB(b, h) + boff + n * 2048 + k * 1024); } while (0)
#define PG8_MMA(ai, bj, At, Bt) do { __builtin_amdgcn_s_setprio(1); _Pragma("unroll") for (int m = 0; m < 4; ++m) _Pragma("unroll") for (int n = 0; n < 2; ++n) _Pragma("unroll") for (int k = 0; k < 2; ++k) \
        acc[ai][bj][m][n] = __builtin_amdgcn_mfma_f32_16x16x32_bf16(Bt[n][k], At[m][k], acc[ai][bj][m][n], 0, 0, 0); __builtin_amdgcn_s_setprio(0); } while (0)
#define PG8_WAIT_V(n) asm volatile("s_waitcnt vmcnt(" #n ")" ::: "memory")
#define PG8_WAIT_L(n) asm volatile("s_waitcnt lgkmcnt(" #n ")" ::: "memory")
#define PG8_BAR __builtin_amdgcn_s_barrier()
#define PG8_SCHED __builtin_amdgcn_sched_barrier(0)
    Unit cur, nxt; int ui = 0;
    if (!S.next(0, cur)) return;
    f32x4 acc[2][2][4][2];
#pragma unroll
    for (int a = 0; a < 2; ++a)
#pragma unroll
        for (int b = 0; b < 2; ++b)
#pragma unroll
            for (int m = 0; m < 4; ++m)
#pragma unroll
                for (int n = 0; n < 2; ++n) acc[a][b][m][n] = (f32x4){0.f, 0.f, 0.f, 0.f};
    bf16x8 At[4][2], B0[2][2], B1[2][2];
    const char* cA = (const char*)g.A + (size_t)cur.pm * tstepA; const char* cB = (const char*)g.Bt + (size_t)cur.pn * tstepB;
    S.a_ready(cur);
    if constexpr (SP2) {
        PG8_STAGE(PG8_SB(0, 0), cB, voffB); PG8_STAGE(PG8_SB(0, 1), cB + hstepB, voffB); PG8_STAGE(PG8_SA(0, 0), cA, voffA); PG8_STAGE(PG8_SA(0, 1), cA + hstepA, voffA);
        if (wr == 1) PG8_BAR;
        PG8_WAIT_V(2); PG8_BAR;
        PG8_STAGE(PG8_SB(1, 0), cB + kstep, voffB); PG8_STAGE(PG8_SA(1, 0), cA + kstep, voffA); PG8_STAGE(PG8_SB(1, 1), cB + hstepB + kstep, voffB);
        PG8_WAIT_V(6); PG8_BAR;
    } else {
        PG8_STAGE(PG8_SB(0, 0), cB, voffB); PG8_STAGE(PG8_SA(0, 0), cA, voffA); PG8_STAGE(PG8_SB(0, 1), cB + hstepB, voffB); PG8_STAGE(PG8_SA(0, 1), cA + hstepA, voffA);
        if (wr == 1) PG8_BAR;
        PG8_WAIT_V(4); PG8_BAR;
        PG8_STAGE(PG8_SB(1, 0), cB + kstep, voffB); PG8_STAGE(PG8_SA(1, 0), cA + kstep, voffA); PG8_STAGE(PG8_SB(1, 1), cB + hstepB + kstep, voffB);
        PG8_WAIT_V(6); PG8_BAR;
    }
    for (;;) {
        const bool has_next = S.next(ui + 1, nxt);
        const char* nA = has_next ? (const char*)g.A + (size_t)nxt.pm * tstepA : cA; const char* nB = has_next ? (const char*)g.Bt + (size_t)nxt.pn * tstepB : cB;
        for (int t = 0; t < nt; t += 2) {
            const bool last = (t == nt - 2);
            const char* a1 = cA + (size_t)(t + 1) * kstep;
            const char* a2 = last ? nA : cA + (size_t)(t + 2) * kstep; const char* b2 = last ? nB : cB + (size_t)(t + 2) * kstep;
            const char* a3 = a2 + kstep; const char* b3 = b2 + kstep;
            if (last && has_next) S.a_ready(nxt);
            if constexpr (SP2) {
            PG8_LDB(B0, 0, 0); PG8_LDB(B1, 0, 1); PG8_SCHED; PG8_LDA(At, 0, 0); PG8_STAGE(PG8_SA(1, 1), a1 + hstepA, voffA);
            PG8_WAIT_V(8); PG8_WAIT_L(0); PG8_BAR; PG8_MMA(0, 0, At, B0); PG8_MMA(0, 1, At, B1); PG8_BAR; PG8_SCHED;
            PG8_LDA(At, 0, 1); PG8_STAGE(PG8_SB(0, 0), b2, voffB); PG8_STAGE(PG8_SB(0, 1), b2 + hstepB, voffB); PG8_STAGE(PG8_SA(0, 0), a2, voffA);
            PG8_WAIT_V(8); PG8_WAIT_L(0); PG8_BAR; PG8_MMA(1, 0, At, B0); PG8_MMA(1, 1, At, B1); PG8_BAR; PG8_SCHED;
            PG8_LDB(B0, 1, 0); PG8_LDB(B1, 1, 1); PG8_SCHED; PG8_LDA(At, 1, 0); PG8_STAGE(PG8_SA(0, 1), a2 + hstepA, voffA);
            PG8_WAIT_V(8); PG8_WAIT_L(0); PG8_BAR; PG8_MMA(0, 0, At, B0); PG8_MMA(0, 1, At, B1); PG8_BAR; PG8_SCHED;
            PG8_LDA(At, 1, 1); PG8_STAGE(PG8_SB(1, 0), b3, voffB); PG8_STAGE(PG8_SB(1, 1), b3 + hstepB, voffB); PG8_STAGE(PG8_SA(1, 0), a3, voffA);
            PG8_WAIT_V(8); PG8_WAIT_L(0); PG8_BAR; PG8_MMA(1, 0, At, B0); PG8_MMA(1, 1, At, B1); PG8_BAR; PG8_SCHED;
            } else {
            PG8_LDB(B0, 0, 0); PG8_SCHED; PG8_LDA(At, 0, 0); PG8_STAGE(PG8_SA(1, 1), a1 + hstepA, voffA);
            PG8_WAIT_L(8); PG8_BAR; PG8_WAIT_L(0); PG8_MMA(0, 0, At, B0); PG8_BAR; PG8_SCHED;
            PG8_LDB(B1, 0, 1); PG8_STAGE(PG8_SB(0, 0), b2, voffB);
            PG8_BAR; PG8_WAIT_L(0); PG8_MMA(0, 1, At, B1); PG8_BAR;
            PG8_LDA(At, 0, 1); PG8_STAGE(PG8_SA(0, 0), a2, voffA);
            PG8_BAR; PG8_WAIT_L(0); PG8_MMA(1, 0, At, B0); PG8_BAR; PG8_SCHED;
            PG8_STAGE(PG8_SB(0, 1), b2 + hstepB, voffB);
            PG8_WAIT_V(6); PG8_BAR; PG8_MMA(1, 1, At, B1); PG8_BAR;
            PG8_LDB(B0, 1, 0); PG8_SCHED; PG8_LDA(At, 1, 0); PG8_STAGE(PG8_SA(0, 1), a2 + hstepA, voffA);
            PG8_WAIT_L(8); PG8_BAR; PG8_WAIT_L(0); PG8_MMA(0, 0, At, B0); PG8_BAR; PG8_SCHED;
            PG8_LDB(B1, 1, 1); PG8_STAGE(PG8_SB(1, 0), b3, voffB);
            PG8_BAR; PG8_WAIT_L(0); PG8_MMA(0, 1, At, B1); PG8_BAR;
            PG8_LDA(At, 1, 1); PG8_STAGE(PG8_SA(1, 0), a3, voffA);
            PG8_BAR; PG8_WAIT_L(0); PG8_MMA(1, 0, At, B0); PG8_BAR; PG8_SCHED;
            PG8_STAGE(PG8_SB(1, 1), b3 + hstepB, voffB);
            PG8_WAIT_V(6); PG8_BAR; PG8_MMA(1, 1, At, B1); PG8_BAR;
            }
        }
        if constexpr (ALIGN_EPI) { if (wr == 0) PG8_BAR; }
        if constexpr (!Epi::AFTER_DRAIN) { E(acc, cur, wr, wc, fr, fq); S.done(cur); }
        if (!has_next) break;
#pragma unroll
        for (int a = 0; a < 2; ++a)
#pragma unroll
            for (int b = 0; b < 2; ++b)
#pragma unroll
                for (int m = 0; m < 4; ++m)
#pragma unroll
                    for (int n = 0; n < 2; ++n) acc[a][b][m][n] = (f32x4){0.f, 0.f, 0.f, 0.f};
        cur = nxt; cA = nA; cB = nB; ++ui;
        if constexpr (ALIGN_EPI) { if (wr == 1) PG8_BAR; }
    }
    PG8_WAIT_V(0);
    if constexpr (!ALIGN_EPI) { if (wr == 0) PG8_BAR; }
    PG8_BAR;
    if constexpr (Epi::AFTER_DRAIN) { E.fused(acc, cur, wr, wc, fr, fq, lds, wid, lane); S.done(cur); }
#undef PG8_SA
#undef PG8_SB
#undef PG8_STAGE
#undef PG8_LDA
#undef PG8_LDB
#undef PG8_MMA
#undef PG8_WAIT_V
#undef PG8_WAIT_L
#undef PG8_BAR
#undef PG8_SCHED
}
}
#define GAS __attribute__((address_space(1)))
#define LAS __attribute__((address_space(3)))
typedef unsigned short bf16;
typedef unsigned v4u __attribute__((ext_vector_type(4)));
typedef float f32x4 __attribute__((ext_vector_type(4)));
typedef short bf16x8 __attribute__((ext_vector_type(8)));
typedef GAS unsigned gu32;
typedef GAS unsigned long long gu64;
#define RLX_AGENT __ATOMIC_RELAXED, __HIP_MEMORY_SCOPE_AGENT
#define LDS_WAIT() asm volatile("s_waitcnt lgkmcnt(0)" ::: "memory")
#define VM_WAIT() asm volatile("s_waitcnt vmcnt(0)" ::: "memory")
__device__ __forceinline__ unsigned long long rt() { return __builtin_amdgcn_s_memrealtime(); }
__device__ __forceinline__ unsigned f2bf(float f) { unsigned u = __builtin_bit_cast(unsigned, f); return (u + 0x7fffu + ((u >> 16) & 1u)) >> 16; }
__device__ __forceinline__ unsigned pk2(float lo, float hi) { return f2bf(lo) | (f2bf(hi) << 16); }

#define XB_TMO      128
#define XB_XCNT(j)  (256  + 64 * (j))
#define XB_XSUB(j)  (1280 + 64 * (j))
#define XB_XGEN(j)  (2304 + 64 * (j))
#define XB_TOP      3328
#define XB_TOPGEN   3392
#define XCD_BAR_WORDS 3456
#define XB_SPIN_CAP (1u << 22)

__device__ __forceinline__ unsigned xb_ld(unsigned* p)              { return __hip_atomic_load(p, __ATOMIC_RELAXED, __HIP_MEMORY_SCOPE_AGENT); }
__device__ __forceinline__ unsigned xb_add(unsigned* p, unsigned v) { return __hip_atomic_fetch_add(p, v, __ATOMIC_RELAXED, __HIP_MEMORY_SCOPE_AGENT); }
__device__ __forceinline__ unsigned xb_xcc_id() { return (unsigned)__builtin_amdgcn_s_getreg((3 << 11) | 20) & 0xFu; }
#define XB_SPIN(cond, bar) do { unsigned _sp = 0; while (cond) { __builtin_amdgcn_s_sleep(1); \
    if ((++_sp & 255u) == 0u) { if (xb_ld(&(bar)[XB_TMO])) break; if (_sp > XB_SPIN_CAP) { atomicAdd(&(bar)[XB_TMO], 1u); break; } } } } while (0)

struct XcdBarrier {
    unsigned* bar; unsigned x;
    volatile LAS unsigned* st;
};

__device__ __forceinline__ XcdBarrier xcd_barrier_post(unsigned* bar, volatile LAS unsigned* st) {
    XcdBarrier b; b.bar = bar; b.x = xb_xcc_id(); b.st = st;
    if (threadIdx.x == 0) (void)xb_add(&bar[XB_XCNT(b.x)], 1u);
    return b;
}
__device__ __forceinline__ void xcd_barrier_complete(unsigned* bar, unsigned x, unsigned& nloc, unsigned& nx) {
    const unsigned G = gridDim.x * gridDim.y * gridDim.z;
    unsigned sum, cnt, mine, sp = 0u;
    for (;;) {
        sum = 0u; cnt = 0u; mine = 0u;
#pragma unroll
        for (unsigned j = 0; j < 16; ++j) { const unsigned c = xb_ld(&bar[XB_XCNT(j)]); sum += c; cnt += (c > 0u) ? 1u : 0u; mine = (j == x) ? c : mine; }
        if (sum == G) break;
        __builtin_amdgcn_s_sleep(1);
        if ((++sp & 255u) == 0u) { if (xb_ld(&bar[XB_TMO])) break; if (sp > XB_SPIN_CAP) { atomicAdd(&bar[XB_TMO], 1u); break; } }
    }
    nloc = mine > 0u ? mine : 1u; nx = cnt > 0u ? cnt : 1u;
}

__device__ __forceinline__ void xcd_barrier(const XcdBarrier& b) {
    asm volatile("s_waitcnt vmcnt(0)" ::: "memory");
    __syncthreads();
    if (threadIdx.x == 0) {
        unsigned* bar = b.bar;
        __builtin_amdgcn_s_waitcnt(0);
        unsigned nloc = b.st[0], nx = b.st[1];
        if (nloc == 0u) { xcd_barrier_complete(bar, b.x, nloc, nx); b.st[0] = nloc; b.st[1] = nx; }
        const unsigned old = xb_add(&bar[XB_XSUB(b.x)], 1u);
        const unsigned gen = old / nloc;
        if (old + 1u == (gen + 1u) * nloc) {
            __builtin_amdgcn_fence(__ATOMIC_RELEASE, "agent");
            asm volatile("s_waitcnt vmcnt(0)" ::: "memory");
            const unsigned og = xb_add(&bar[XB_TOP], 1u);
            const unsigned tg = og / nx;
            if (og + 1u == (tg + 1u) * nx) xb_add(&bar[XB_TOPGEN], 1u);
            else XB_SPIN(xb_ld(&bar[XB_TOPGEN]) == tg, bar);
            __builtin_amdgcn_fence(__ATOMIC_ACQUIRE, "agent");
            xb_add(&bar[XB_XGEN(b.x)], 1u);
            asm volatile("s_waitcnt vmcnt(0)" ::: "memory");
        } else {
            XB_SPIN(xb_ld(&bar[XB_XGEN(b.x)]) == gen, bar);
            __builtin_amdgcn_fence(__ATOMIC_ACQUIRE, "agent");
            asm volatile("s_waitcnt vmcnt(0)" ::: "memory");
        }
    }
    __syncthreads();
}

constexpr int NWAVES = 8;
constexpr int BATCH = 8, T = 2048, D = 1024, M = BATCH * T;
constexpr int IN_COLS = 9224;
constexpr int NPROJ = 7168;
constexpr int C_DNQ = 0, C_DNK = 512, C_DNV = 1024, C_DNZ = 1536, C_SQ = 2048, C_SK = 3584, C_SV = 5120, C_SZ = 6656;
constexpr int C_MERGED = 0, C_SCR1 = 2048, C_SCR2 = 3584, C_SCR3 = 5120;
constexpr float EPS = 1e-6f;
constexpr float QK_SCALE = 0.08838834764831845f;

constexpr size_t MiB = 1u << 20;
constexpr size_t WS_CTL = 0, CTL_ZERO_BYTES = 1 * MiB;
constexpr size_t WS_BG = 1 * MiB;
constexpr size_t WS_ROPE = 1 * MiB + 512 * 1024;
constexpr size_t WS_WG = 2 * MiB;
constexpr size_t WS_WDN = 6 * MiB, WS_WSWA = 7 * MiB;
constexpr size_t WS_WOUT = 8 * MiB;
constexpr size_t WS_WIN = 10 * MiB;
constexpr size_t WS_PROJ = 32 * MiB;
constexpr size_t WS_END = 256 * MiB;
static_assert(WS_WIN + (size_t)NPROJ * D * 2 <= WS_PROJ && WS_PROJ + (size_t)M * NPROJ * 2 <= WS_END, "d_ws map");
constexpr int CW_BAR = 4096;

constexpr int RING_OFF = 0, RING_BYTES = 131072;
constexpr int LDSCTL_OFF = RING_BYTES, MISC_OFF = LDSCTL_OFF + 320;
constexpr int LDS_BYTES = 147456;


struct Frame {
    LAS unsigned char* lds;
    volatile LAS unsigned* MISC;
    gu32* ctl;
    int tid, lane, wave;
    int vcu, G;
    const float *x, *norm_w, *w_in, *conv_w, *a_log, *dt_bias, *dn_norm_w, *q_norm_w, *k_norm_w, *w_bdn, *w_bswa, *w_out;
    float* out;
    bf16 *WinT, *WgT, *WdnT, *WswaT, *WoutT, *H, *PROJ;
    float* BG; float* ROPE;
};
__device__ __forceinline__ float wave_sum(float v) {
#pragma unroll
    for (int o = 1; o < 64; o <<= 1) v += __shfl_xor(v, o);
    return v;
}
__device__ __forceinline__ float wave_max(float v) {
#pragma unroll
    for (int o = 1; o < 64; o <<= 1) v = fmaxf(v, __shfl_xor(v, o));
    return v;
}
__device__ __forceinline__ float bf_lo(unsigned w) { return __builtin_bit_cast(float, w << 16); }
__device__ __forceinline__ float bf_hi(unsigned w) { return __builtin_bit_cast(float, w & 0xffff0000u); }
__device__ __forceinline__ float bf2f(bf16 v) { return __builtin_bit_cast(float, (unsigned)v << 16); }
__device__ __forceinline__ float siluf_(float a) { return a / (1.0f + __expf(-a)); }
__device__ __forceinline__ float sigm_(float a) { return 1.0f / (1.0f + __expf(-a)); }

__device__ __forceinline__ void transpose_item(const float* Wsrc, int ldw, bf16* WTdst, int K, int k0, LAS float* scr, int lane) {
#pragma unroll 8
    for (int i = 0; i < 32; ++i) { const int kk = 2 * i + (lane >> 5); scr[kk * 33 + (lane & 31)] = Wsrc[(size_t)(k0 + kk) * ldw + (lane & 31)]; }
    LDS_WAIT(); asm volatile("" ::: "memory");
    const int c = lane & 7;
#pragma unroll
    for (int j = 0; j < 4; ++j) { const int n = (lane >> 3) + 8 * j; const LAS float* s = scr + (8 * c) * 33 + n;
        v4u o; o.x = pk2(s[0 * 33], s[1 * 33]); o.y = pk2(s[2 * 33], s[3 * 33]); o.z = pk2(s[4 * 33], s[5 * 33]); o.w = pk2(s[6 * 33], s[7 * 33]);
        *(GAS v4u*)(WTdst + (size_t)n * K + k0 + 8 * c) = o; }
    LDS_WAIT(); asm volatile("" ::: "memory");
}
__device__ __forceinline__ void p0_prologue(Frame& F) {
    LAS float* scr = (LAS float*)(F.lds + RING_OFF + F.wave * 16384);
    const int gw = F.vcu * NWAVES + F.wave, NGW = F.G * NWAVES, lane = F.lane;
    constexpr int I_IN = 16 * (NPROJ / 32), I_G = 16 * 64, I_DN = 8 * 32, I_SWA = 8 * 32, I_OUT = 16 * 32;
    constexpr int NITEMS = I_IN + I_G + I_DN + I_SWA + I_OUT;
    for (int it = gw; it < NITEMS; it += NGW) {
        int r = it;
        if (r < I_IN) { const int kb = r / (NPROJ / 32), nb = r % (NPROJ / 32), n0 = nb * 32, src = n0 < 2048 ? n0 : n0 + 8;
            transpose_item(F.w_in + src, IN_COLS, F.WinT + (size_t)n0 * D, D, kb * 64, scr, lane); continue; } r -= I_IN;
        if (r < I_G) { const int kb = r / 64, nb = r % 64, n0 = nb * 32;
            transpose_item(F.w_in + 7176 + n0, IN_COLS, F.WgT + (size_t)n0 * D, D, kb * 64, scr, lane); continue; } r -= I_G;
        if (r < I_DN) { const int kb = r / 32, nb = r % 32, n0 = nb * 32;
            transpose_item(F.w_bdn + n0, D, F.WdnT + (size_t)n0 * 512, 512, kb * 64, scr, lane); continue; } r -= I_DN;
        if (r < I_SWA) { const int kb = r / 32, nb = r % 32, n0 = nb * 32;
            transpose_item(F.w_bswa + n0, D, F.WswaT + (size_t)n0 * 512, 512, kb * 64, scr, lane); continue; } r -= I_SWA;
        { const int kb = r / 32, nb = r % 32, n0 = nb * 32;
            transpose_item(F.w_out + n0, D, F.WoutT + (size_t)n0 * D, D, kb * 64, scr, lane); }
    }
    {
        static constexpr double INVF[16] = {1.0, 0.44036660267178046, 0.19392274474868576, 0.08539710028576561, 0.03760603093086393, 0.016560440080994446, 0.007292664737217109, 0.003211445994752591,
                                            0.001414213562373095, 0.000622772421914596, 0.0002742481756762073, 0.00012076973741146504, 5.318295896944988e-05, 2.341999896140934e-05, 1.031338537721246e-05, 4.5416704806078695e-06};
        for (int gt = F.vcu * (NWAVES * 64) + F.tid; gt < T * 16; gt += F.G * NWAVES * 64) {
            const int pos = gt >> 4, i = gt & 15;
            double a = (double)pos * INVF[i] * 0.15915494309189535;
            a -= __builtin_rint(a);
            const float af = (float)a;
            F.ROPE[gt * 2] = __builtin_amdgcn_cosf(af); F.ROPE[gt * 2 + 1] = __builtin_amdgcn_sinf(af);
        }
    }
    __syncthreads();
    LAS float* wsm = (LAS float*)(F.lds + RING_OFF);
    for (int idx = F.tid; idx < 1024 * 8; idx += NWAVES * 64) { const int k = idx >> 3, j = idx & 7; const float v = F.w_in[(size_t)k * IN_COLS + 2048 + j];
        const int ln = (k & 255) >> 2, e = k & 3, jj = k >> 8, c = jj * 4 + e, half = j >> 2; wsm[((half * 16 + c) * 64 + ln) * 4 + (j & 3)] = v; }
    __syncthreads();
    for (int m = gw; m < M; m += NGW) {
        const GAS f32x4* xr = (const GAS f32x4*)(F.x + (size_t)m * D) + lane;
        f32x4 v[4]; float ss = 0.f;
#pragma unroll
        for (int j = 0; j < 4; ++j) { v[j] = xr[64 * j]; ss += (v[j].x * v[j].x + v[j].y * v[j].y) + (v[j].z * v[j].z + v[j].w * v[j].w); }
        const float rstd = 1.0f / sqrtf(wave_sum(ss) * (1.f / D) + EPS);
#pragma unroll
        for (int j = 0; j < 4; ++j) { const f32x4 nw = ((const GAS f32x4*)F.norm_w)[lane + 64 * j]; v[j] = (v[j] * rstd) * nw; }
        GAS unsigned long long* o8 = (GAS unsigned long long*)(F.H + (size_t)m * D) + lane;
#pragma unroll
        for (int j = 0; j < 4; ++j) o8[64 * j] = (unsigned long long)pk2(v[j].x, v[j].y) | ((unsigned long long)pk2(v[j].z, v[j].w) << 32);
        f32x4 plo = {0.f, 0.f, 0.f, 0.f}, phi = {0.f, 0.f, 0.f, 0.f};
#pragma unroll
        for (int jj = 0; jj < 4; ++jj)
#pragma unroll
            for (int e = 0; e < 4; ++e) { const int c = jj * 4 + e; const float hv = v[jj][e];
                const f32x4 wlo = *(const LAS f32x4*)(wsm + ((0 * 16 + c) * 64 + lane) * 4), whi = *(const LAS f32x4*)(wsm + ((1 * 16 + c) * 64 + lane) * 4);
                plo += wlo * hv; phi += whi * hv; }
        const float p0 = wave_sum(plo.x), p1 = wave_sum(plo.y), p2 = wave_sum(plo.z), p3 = wave_sum(plo.w), p4 = wave_sum(phi.x), p5 = wave_sum(phi.y), p6 = wave_sum(phi.z), p7 = wave_sum(phi.w);
        float val = p0; val = lane == 1 ? p1 : val; val = lane == 2 ? p2 : val; val = lane == 3 ? p3 : val; val = lane == 4 ? p4 : val; val = lane == 5 ? p5 : val; val = lane == 6 ? p6 : val; val = lane == 7 ? p7 : val;
        if (lane < 8) { const int h = lane & 3; float o;
            if (lane < 4) o = sigm_(val);
            else { const float xx = val + F.dt_bias[h]; const float sp = xx > 20.f ? xx : log1pf(expf(xx)); o = -expf(F.a_log[h]) * sp; }
            F.BG[(size_t)m * 8 + lane] = o; }
    }
}

__device__ __forceinline__ void p2_swa_norm(Frame& F) {
    const int gw = F.vcu * NWAVES + F.wave, NGW = F.G * NWAVES, lane = F.lane, hh = lane >> 4, l16 = lane & 15;
    for (int it = gw; it < M * 2; it += NGW) {
        const int row = it >> 1, which = it & 1, t = row & (T - 1);
        bf16* base = F.PROJ + (size_t)row * NPROJ + (which ? C_SK : C_SQ);
        const float* nwp = which ? F.k_norm_w : F.q_norm_w;
        const GAS f32x4* rp = (const GAS f32x4*)(F.ROPE + ((size_t)t * 16 + (l16 & 1) * 8) * 2);
        const f32x4 r0 = rp[0], r1 = rp[1], r2 = rp[2], r3 = rp[3];
        const float cs[8] = {r0.x, r0.z, r1.x, r1.z, r2.x, r2.z, r3.x, r3.z}, sn[8] = {r0.y, r0.w, r1.y, r1.w, r2.y, r2.w, r3.y, r3.w};
#pragma unroll
        for (int g = 0; g < 3; ++g) {
            bf16* p = base + g * 512 + hh * 128 + l16 * 8;
            const v4u raw = *(const GAS v4u*)p;
            float x[8] = {bf_lo(raw.x), bf_hi(raw.x), bf_lo(raw.y), bf_hi(raw.y), bf_lo(raw.z), bf_hi(raw.z), bf_lo(raw.w), bf_hi(raw.w)};
            float ss = 0.f;
#pragma unroll
            for (int e = 0; e < 8; ++e) ss += x[e] * x[e];
            ss += __shfl_xor(ss, 1); ss += __shfl_xor(ss, 2); ss += __shfl_xor(ss, 4); ss += __shfl_xor(ss, 8);
            const float rstd = 1.0f / sqrtf(ss * (1.f / 128.f) + EPS);
            const f32x4 w0 = *(const GAS f32x4*)(nwp + g * 128 + l16 * 8), w1 = *(const GAS f32x4*)(nwp + g * 128 + l16 * 8 + 4);
            const float w[8] = {w0.x, w0.y, w0.z, w0.w, w1.x, w1.y, w1.z, w1.w};
            float y[8];
#pragma unroll
            for (int e = 0; e < 8; ++e) y[e] = (x[e] * rstd) * w[e];
#pragma unroll
            for (int e = 0; e < 8; ++e) { const float pr = __shfl_xor(y[e], 2);
                const float rot = (l16 < 2) ? (y[e] * cs[e] - pr * sn[e]) : (y[e] * cs[e] + pr * sn[e]);
                y[e] = (l16 < 4) ? rot : y[e]; }
            v4u o; o.x = pk2(y[0], y[1]); o.y = pk2(y[2], y[3]); o.z = pk2(y[4], y[5]); o.w = pk2(y[6], y[7]);
            *(GAS v4u*)p = o;
        }
    }
}

__device__ __forceinline__ void p2_attn_naive(Frame& F, int widx, int nwv) {
    const int lane = F.lane;
    LAS float* pw = (LAS float*)(F.lds + RING_OFF + 96 * 1024 + F.wave * 2048);
    for (int it = widx; it < M * 4; it += nwv) {
        const int row = it >> 2, h = it & 3, t = row & (T - 1);
        float sc[3][3];
#pragma unroll
        for (int g = 0; g < 3; ++g) {
            const int sh = 2 * g;
            const GAS v4u* qp = (const GAS v4u*)(F.PROJ + (size_t)row * NPROJ + C_SQ + g * 512 + h * 128);
            v4u q[16];
#pragma unroll
            for (int i = 0; i < 16; ++i) q[i] = qp[i];
#pragma unroll
            for (int s = 0; s < 3; ++s) {
                const int d = s < 2 ? lane + 64 * s : 128; const bool valid = (s < 2 || lane == 0) && (t - (d << sh) >= 0);
                float dot = 0.f;
                if (valid) { const GAS v4u* kp = (const GAS v4u*)(F.PROJ + (size_t)(row - (d << sh)) * NPROJ + C_SK + g * 512 + h * 128);
#pragma unroll
                    for (int i = 0; i < 16; ++i) { const v4u kv = kp[i];
                        dot += bf_lo(q[i].x) * bf_lo(kv.x) + bf_hi(q[i].x) * bf_hi(kv.x) + bf_lo(q[i].y) * bf_lo(kv.y) + bf_hi(q[i].y) * bf_hi(kv.y)
                             + bf_lo(q[i].z) * bf_lo(kv.z) + bf_hi(q[i].z) * bf_hi(kv.z) + bf_lo(q[i].w) * bf_lo(kv.w) + bf_hi(q[i].w) * bf_hi(kv.w); } }
                sc[g][s] = valid ? dot * QK_SCALE : -INFINITY;
            }
        }
        float mx = -INFINITY;
#pragma unroll
        for (int g = 0; g < 3; ++g)
#pragma unroll
            for (int s = 0; s < 3; ++s) mx = fmaxf(mx, sc[g][s]);
        mx = wave_max(mx);
        float lsum = 0.f;
#pragma unroll
        for (int g = 0; g < 3; ++g)
#pragma unroll
            for (int s = 0; s < 3; ++s) { const float p = __expf(sc[g][s] - mx); lsum += p;
                if (s < 2) pw[g * 132 + lane + 64 * s] = p; else if (lane == 0) pw[g * 132 + 128] = p; }
        lsum = wave_sum(lsum);
        LDS_WAIT(); asm volatile("" ::: "memory");
        float o0 = 0.f, o1 = 0.f;
#pragma unroll
        for (int g = 0; g < 3; ++g) { const int sh = 2 * g; int n = t >> sh; n = (n < 128 ? n : 128) + 1;
            const GAS unsigned* vp = (const GAS unsigned*)(F.PROJ + (size_t)row * NPROJ + C_SV + g * 512 + h * 128) + lane;
            for (int d = 0; d < n; ++d) { const float p = pw[g * 132 + d]; const unsigned v = *(vp - (size_t)(d << sh) * (NPROJ / 2)); o0 += p * bf_lo(v); o1 += p * bf_hi(v); } }
        const float inv = 1.0f / lsum;
        GAS unsigned* zp = (GAS unsigned*)(F.PROJ + (size_t)row * NPROJ + C_SZ + h * 128) + lane;
        const unsigned z = *zp;
        *zp = pk2(o0 * inv * siluf_(bf_lo(z)), o1 * inv * siluf_(bf_hi(z)));
        LDS_WAIT(); asm volatile("" ::: "memory");
    }
}

__device__ __forceinline__ void p2_dn_naive(Frame& F, int bh) {
    const int b = bh >> 2, h = bh & 3, tid = F.tid, dv = tid >> 2, kq = tid & 3;
    LAS float* QS = (LAS float*)(F.lds + RING_OFF); LAS float* KS = QS + 4096; LAS float* VS = KS + 4096; LAS float* OS = VS + 4096; LAS float* BGs = OS + 4096;
    float S[32];
#pragma unroll
    for (int i = 0; i < 32; ++i) S[i] = 0.f;
    for (int tb = 0; tb < T / 32; ++tb) { const int t0 = tb * 32;
        for (int idx = tid; idx < 32 * 384; idx += NWAVES * 64) { const int tt = idx / 384, c = idx - tt * 384, which = c >> 7, cc = c & 127, ch = which * 512 + h * 128 + cc, t = t0 + tt;
            float a = 0.f;
#pragma unroll
            for (int j = 0; j < 4; ++j) { const int tp = t - 3 + j; if (tp >= 0) a += F.conv_w[j * 1536 + ch] * bf2f(F.PROJ[(size_t)(b * T + tp) * NPROJ + C_DNQ + ch]); }
            const float y = siluf_(a);
            LAS float* dst = which == 0 ? QS : (which == 1 ? KS : VS); dst[tt * 128 + cc] = y; }
        if (tid < 32) { const float* bg = F.BG + (size_t)(b * T + t0 + tid) * 8; BGs[tid * 2] = bg[h]; BGs[tid * 2 + 1] = __expf(bg[4 + h]); }
        __syncthreads();
        { const int vec = tid >> 3, sub = tid & 7; LAS float* arr = (vec < 32 ? QS : KS) + (vec & 31) * 128 + sub * 16; float ss = 0.f;
#pragma unroll
            for (int i = 0; i < 16; ++i) ss += arr[i] * arr[i];
            ss += __shfl_xor(ss, 1); ss += __shfl_xor(ss, 2); ss += __shfl_xor(ss, 4);
            const float scl = (1.0f / sqrtf(ss + EPS)) * (vec < 32 ? QK_SCALE : 1.f);
#pragma unroll
            for (int i = 0; i < 16; ++i) arr[i] *= scl; }
        __syncthreads();
        for (int tt = 0; tt < 32; ++tt) {
            const LAS float* kp = KS + tt * 128 + kq * 32; const LAS float* qp = QS + tt * 128 + kq * 32;
            float kk[32]; float part = 0.f;
#pragma unroll
            for (int i = 0; i < 32; ++i) { kk[i] = kp[i]; part += kk[i] * S[i]; }
            part += __shfl_xor(part, 1); part += __shfl_xor(part, 2);
            const float beta = BGs[tt * 2], eg = BGs[tt * 2 + 1], vv = VS[tt * 128 + dv];
            const float cf = beta * (vv - eg * part);
            float op = 0.f;
#pragma unroll
            for (int i = 0; i < 32; ++i) { S[i] = eg * S[i] + kk[i] * cf; op += qp[i] * S[i]; }
            op += __shfl_xor(op, 1); op += __shfl_xor(op, 2);
            if (kq == 0) OS[tt * 128 + dv] = op;
        }
        __syncthreads();
        { const int tt = tid >> 4, sub = tid & 15; const LAS float* op = OS + tt * 128 + sub * 8; float o[8]; float ss = 0.f;
#pragma unroll
            for (int e = 0; e < 8; ++e) { o[e] = op[e]; ss += o[e] * o[e]; }
            ss += __shfl_xor(ss, 1); ss += __shfl_xor(ss, 2); ss += __shfl_xor(ss, 4); ss += __shfl_xor(ss, 8);
            const float rstd = 1.0f / sqrtf(ss * (1.f / 128.f) + EPS);
            bf16* zp = F.PROJ + (size_t)(b * T + t0 + tt) * NPROJ + C_DNZ + h * 128 + sub * 8; const v4u zr = *(const GAS v4u*)zp;
            const float z[8] = {bf_lo(zr.x), bf_hi(zr.x), bf_lo(zr.y), bf_hi(zr.y), bf_lo(zr.z), bf_hi(zr.z), bf_lo(zr.w), bf_hi(zr.w)};
            float r[8];
#pragma unroll
            for (int e = 0; e < 8; ++e) r[e] = (o[e] * rstd) * F.dn_norm_w[sub * 8 + e] * siluf_(z[e]);
            v4u ov; ov.x = pk2(r[0], r[1]); ov.y = pk2(r[2], r[3]); ov.z = pk2(r[4], r[5]); ov.w = pk2(r[6], r[7]);
            *(GAS v4u*)zp = ov; }
        __syncthreads();
    }
}

struct Args { const float* in[12]; float* out; unsigned char* ws; int ph_lo, ph_hi; };
__global__ void __launch_bounds__(NWAVES * 64, 2) fwd_kernel(Args args) {
    extern __shared__ __attribute__((aligned(16))) unsigned char lds[];
    Frame F;
    F.lds = (LAS unsigned char*)lds;
    F.MISC = (volatile LAS unsigned*)(F.lds + MISC_OFF);
    F.tid = threadIdx.x; F.lane = F.tid & 63; F.wave = __builtin_amdgcn_readfirstlane(F.tid >> 6);
    F.G = gridDim.x; { const int bx = blockIdx.x; F.vcu = (F.G % 8 == 0) ? (bx % 8) * (F.G / 8) + bx / 8 : bx; }
    unsigned char* ws = args.ws;
    F.ctl = (gu32*)(ws + WS_CTL);
    F.x = args.in[0]; F.norm_w = args.in[1]; F.w_in = args.in[2]; F.conv_w = args.in[3]; F.a_log = args.in[4]; F.dt_bias = args.in[5]; F.dn_norm_w = args.in[6];
    F.q_norm_w = args.in[7]; F.k_norm_w = args.in[8]; F.w_bdn = args.in[9]; F.w_bswa = args.in[10]; F.w_out = args.in[11]; F.out = args.out;
    F.WinT = (bf16*)(ws + WS_WIN); F.WgT = (bf16*)(ws + WS_WG); F.WdnT = (bf16*)(ws + WS_WDN); F.WswaT = (bf16*)(ws + WS_WSWA); F.WoutT = (bf16*)(ws + WS_WOUT);
    F.H = (bf16*)args.out; F.PROJ = (bf16*)(ws + WS_PROJ); F.BG = (float*)(ws + WS_BG); F.ROPE = (float*)(ws + WS_ROPE);
    for (int u = F.tid; u < (LDS_BYTES - LDSCTL_OFF) / 4; u += NWAVES * 64) ((LAS unsigned*)(F.lds + LDSCTL_OFF))[u] = 0u;
    __syncthreads();
    XcdBarrier bar = xcd_barrier_post((unsigned*)(F.ctl + CW_BAR), F.MISC + 8);
    const int lo = args.ph_lo, hi = args.ph_hi;
#define IN(k) (lo <= (k) && (k) < hi)
#define BOTH(k) (IN(k) && IN((k) + 1))
#define GRID_BAR() xcd_barrier(bar)

    if (IN(0)) { p0_prologue(F); if (BOTH(0)) GRID_BAR(); }

    if (IN(1)) {
        pg8::Gemm g{F.H, F.WinT, M, NPROJ, D, D, D}; pg8::StaticOrder S; S.init(M, NPROJ, F.G, (int)blockIdx.x);
        pg8::EpiBf<0> E{F.PROJ, nullptr, nullptr, NPROJ};
        pg8::gemm_phase<pg8::EpiBf<0>, pg8::StaticOrder, true, true>(F.lds + RING_OFF, g, S, E);
        if (BOTH(1)) GRID_BAR();
    }
    if (IN(2)) { p2_swa_norm(F); if (BOTH(2)) GRID_BAR(); }
    if (IN(3)) {
        if (F.vcu < 32) p2_dn_naive(F, F.vcu);
        else p2_attn_naive(F, (F.vcu - 32) * NWAVES + F.wave, (F.G - 32) * NWAVES);
        if (BOTH(3)) GRID_BAR();
    }
    if (IN(4)) {
        pg8::StaticOrder S; S.init(M, D, F.G, (int)blockIdx.x);
        { pg8::Gemm g{F.H, F.WgT, M, D, D, D, D}; pg8::EpiBf<1> E{F.PROJ + C_SCR1, nullptr, nullptr, NPROJ};
          pg8::gemm_phase<pg8::EpiBf<1>, pg8::StaticOrder, false, true>(F.lds + RING_OFF, g, S, E); }
        { pg8::Gemm g{F.PROJ + C_DNZ, F.WdnT, M, D, 512, NPROJ, 512}; pg8::EpiBf<2> E{F.PROJ + C_SCR2, F.PROJ + C_SCR1, nullptr, NPROJ};
          pg8::gemm_phase<pg8::EpiBf<2>, pg8::StaticOrder, false, true>(F.lds + RING_OFF, g, S, E); }
        { pg8::Gemm g{F.H, F.WgT + (size_t)1024 * D, M, D, D, D, D}; pg8::EpiBf<1> E{F.PROJ + C_SCR3, nullptr, nullptr, NPROJ};
          pg8::gemm_phase<pg8::EpiBf<1>, pg8::StaticOrder, false, true>(F.lds + RING_OFF, g, S, E); }
        { pg8::Gemm g{F.PROJ + C_SZ, F.WswaT, M, D, 512, NPROJ, 512}; pg8::EpiBf<3> E{F.PROJ + C_MERGED, F.PROJ + C_SCR3, F.PROJ + C_SCR2, NPROJ};
          pg8::gemm_phase<pg8::EpiBf<3>, pg8::StaticOrder, false, true>(F.lds + RING_OFF, g, S, E); }
        if (BOTH(4)) GRID_BAR();
    }
    if (IN(5)) {
        pg8::Gemm g{F.PROJ + C_MERGED, F.WoutT, M, D, D, NPROJ, D}; pg8::StaticOrder S; S.init(M, D, F.G, (int)blockIdx.x);
        pg8::EpiRes E{F.x, F.out, D};
        pg8::gemm_phase<pg8::EpiRes, pg8::StaticOrder, false, true>(F.lds + RING_OFF, g, S, E);
    }
#undef IN
#undef BOTH
#undef GRID_BAR
}

#ifndef N_LAUNCHES
#define N_LAUNCHES 1
#endif
extern "C" void kernel_launch(void* const* d_in, const int* in_sizes, int n_in, void* d_out, int out_size, void* d_ws, size_t ws_size, hipStream_t stream) {
    static int grid = 0;
    if (grid == 0) {
        if (n_in != 12 || in_sizes[0] != M * D || out_size != M * D || ws_size < WS_END) { fprintf(stderr, "kernel_launch: unexpected shapes (n_in %d, in0 %d, out %d, ws %zu); nothing launched\n", n_in, n_in > 0 ? in_sizes[0] : -1, out_size, ws_size); grid = -1; return; }
        int dev = 0, cus = 0, per_cu = 0;
        if (hipGetDevice(&dev) != hipSuccess || hipDeviceGetAttribute(&cus, hipDeviceAttributeMultiprocessorCount, dev) != hipSuccess) { grid = -1; return; }
        if (hipFuncSetAttribute((const void*)fwd_kernel, hipFuncAttributeMaxDynamicSharedMemorySize, LDS_BYTES) != hipSuccess) { fprintf(stderr, "kernel_launch: hipFuncSetAttribute failed\n"); grid = -1; return; }
        if (hipOccupancyMaxActiveBlocksPerMultiprocessor(&per_cu, (const void*)fwd_kernel, NWAVES * 64, LDS_BYTES) != hipSuccess || per_cu < 1) { fprintf(stderr, "kernel_launch: occupancy query says %d blocks per CU; nothing launched\n", per_cu); (void)hipGetLastError(); grid = -1; return; }
        grid = cus;
    }
    if (grid < 0) return;
    (void)hipMemsetAsync((char*)d_ws + WS_CTL, 0, CTL_ZERO_BYTES, stream);
    Args a{};
    for (int i = 0; i < 12; ++i) a.in[i] = (const float*)d_in[i];
    a.out = (float*)d_out; a.ws = (unsigned char*)d_ws;
    constexpr int NPH = 6;
#if N_LAUNCHES == 1
    a.ph_lo = 0; a.ph_hi = NPH;
    hipLaunchKernelGGL(fwd_kernel, dim3(grid), dim3(NWAVES * 64), LDS_BYTES, stream, a);
#else
    for (int p = 0; p < NPH; ++p) { a.ph_lo = p; a.ph_hi = p + 1; hipLaunchKernelGGL(fwd_kernel, dim3(grid), dim3(NWAVES * 64), LDS_BYTES, stream, a); }
#endif
}
```

```cpp
#include <hip/hip_runtime.h>
#include <cstdio>
#include <cstdint>
namespace pg8 {
#define PG8_LAS __attribute__((address_space(3)))
typedef unsigned short bf16_t;
typedef short bf16x8 __attribute__((ext_vector_type(8)));
typedef float f32x4 __attribute__((ext_vector_type(4)));
typedef unsigned u32x4 __attribute__((ext_vector_type(4)));
constexpr int BM = 256, BK = 64, HALF = 128, HTB = HALF * BK * 2  , STAGE_BYTES = 8 * HTB, NXCD = 8, WGM = 4;

__host__ __device__ __forceinline__ int lds_byte(int r, int c) { const int st = (r >> 4) * 2 + (c >> 5), rr = r & 15, cc = c & 31, ob = rr * 64 + cc * 2; return st * 1024 + (ob ^ (((ob >> 9) & 1) << 5)); }
__host__ __device__ __forceinline__ void stage_rc(int b, int& R, int& C) { const int st = b / 1024, sb = b % 1024, swz = sb ^ (((sb >> 9) & 1) << 5); R = (st >> 1) * 16 + swz / 64; C = (st & 1) * 32 + (swz % 64) / 2; }
__host__ __device__ __forceinline__ int perm32(int rho) { const int n = rho >> 4, i = rho & 15; return 8 * (i >> 2) + 4 * n + (i & 3); }

struct Unit { int pm, pn; };
struct Gemm { const bf16_t* A; const bf16_t* Bt; int M, N, K, lda, ldb; };

struct StaticOrder {
    int nM, nN, nwg, G, c;
    __host__ __device__ void init(int M, int N, int G_, int c_) { nM = M / BM; nN = N / BM; nwg = nM * nN; G = G_; c = c_; }
    __host__ __device__ bool next(int i, Unit& u) const {
        const long L = (long)i * G + c; if (L >= nwg) return false;
        int wgid = (int)L; { const int q = nwg / NXCD, r = nwg % NXCD, xcd = wgid % NXCD, off = wgid / NXCD; wgid = (xcd < r ? xcd * (q + 1) : r * (q + 1) + (xcd - r) * q) + off; }
        const int nig = WGM * nN, gid = wgid / nig, fm = gid * WGM, gsz = (nM - fm) < WGM ? (nM - fm) : WGM;
        u.pm = fm + ((wgid % nig) % gsz); u.pn = (wgid % nig) / gsz; return true;
    }
    __device__ __forceinline__ void a_ready(const Unit&) const {}
    __device__ __forceinline__ void done(const Unit&) const {}
};

typedef float f32x2_t __attribute__((ext_vector_type(2))); typedef __bf16 bf16x2_t __attribute__((ext_vector_type(2)));
__device__ __forceinline__ unsigned cvt_pk_bf16(float lo, float hi) { const f32x2_t v = {lo, hi}; const bf16x2_t b = __builtin_convertvector(v, bf16x2_t); return __builtin_bit_cast(unsigned, b); }
__device__ __forceinline__ float bf_lo(unsigned w) { return __builtin_bit_cast(float, w << 16); }
__device__ __forceinline__ float bf_hi(unsigned w) { return __builtin_bit_cast(float, w & 0xffff0000u); }
__device__ __forceinline__ float sigmoidf_(float x) { return __builtin_amdgcn_rcpf(1.0f + __expf(-x)); }

template <int MODE> struct EpiBf {
    static constexpr bool PERM = true, AFTER_DRAIN = false;
    bf16_t* O; const bf16_t* S1; const bf16_t* S2; int ldc; bf16_t* halo;
    const float* qnw; const float* knw; const float* rope; PG8_LAS float* xch;
    __device__ __forceinline__ void operator()(const f32x4 (&acc)[2][2][4][2], const Unit& u, int wr, int wc, int fr, int fq) const {
        const int row0 = u.pm * BM + wr * 64 + fr; const int col0 = u.pn * BM + wc * 32 + 8 * fq;
        if (MODE == 0 && qnw != nullptr && u.pn >= 8 && u.pn < 20) {
            const int which = u.pn >= 14 ? 1 : 0, g = (u.pn - (which ? 14 : 8)) >> 1;
#pragma unroll
            for (int ai = 0; ai < 2; ++ai)
#pragma unroll
                for (int m = 0; m < 4; ++m)
#pragma unroll
                    for (int bj = 0; bj < 2; ++bj) { const f32x4 v0 = acc[ai][bj][m][0], v1 = acc[ai][bj][m][1];
                        float s = (v0[0] * v0[0] + v0[1] * v0[1]) + (v0[2] * v0[2] + v0[3] * v0[3]) + (v1[0] * v1[0] + v1[1] * v1[1]) + (v1[2] * v1[2] + v1[3] * v1[3]);
                        { const auto t = __builtin_amdgcn_permlane16_swap(__float_as_uint(s), __float_as_uint(s), false, false); s = __uint_as_float(t[0]) + __uint_as_float(t[1]); }
                        { const auto t = __builtin_amdgcn_permlane32_swap(__float_as_uint(s), __float_as_uint(s), false, false); s = __uint_as_float(t[0]) + __uint_as_float(t[1]); }
                        if (fq == 0) xch[(ai * HALF + wr * 64 + m * 16 + fr) * 8 + bj * 4 + wc] = s; }
            asm volatile("s_waitcnt lgkmcnt(0)" ::: "memory"); __builtin_amdgcn_s_barrier(); asm volatile("" ::: "memory");
            const float* nwp = (which ? knw : qnw) + g * 128 + wc * 32 + fq * 8;
            const f32x4 w0 = *(const f32x4*)nwp, w1 = *(const f32x4*)(nwp + 4);
            f32x4 c0 = {1.f, 1.f, 1.f, 1.f}, c1 = c0, s0 = {0.f, 0.f, 0.f, 0.f}, s1 = s0, cd[2], sd[2];
            if (wc == 0) {
                { const f32x4* rp = (const f32x4*)(rope + ((size_t)(row0 & 2047) * 16 + (fq & 1) * 8) * 2); const f32x4 r0 = rp[0], r1 = rp[1], r2 = rp[2], r3 = rp[3];
                    c0 = (f32x4){r0[0], r0[2], r1[0], r1[2]}; c1 = (f32x4){r2[0], r2[2], r3[0], r3[2]}; s0 = (f32x4){r0[1], r0[3], r1[1], r1[3]}; s1 = (f32x4){r2[1], r2[3], r3[1], r3[3]}; }
                { const f32x4* rp = (const f32x4*)(rope + ((size_t)16 * 16 + (fq & 1) * 8) * 2); const f32x4 r0 = rp[0], r1 = rp[1], r2 = rp[2], r3 = rp[3];
                    cd[0] = (f32x4){r0[0], r0[2], r1[0], r1[2]}; cd[1] = (f32x4){r2[0], r2[2], r3[0], r3[2]}; sd[0] = (f32x4){r0[1], r0[3], r1[1], r1[3]}; sd[1] = (f32x4){r2[1], r2[3], r3[1], r3[3]}; }
            }
            const float sgn = fq < 2 ? -1.f : 1.f;
#pragma unroll
            for (int ai = 0; ai < 2; ++ai) {
#pragma unroll
                for (int m = 0; m < 4; ++m) { const int row = row0 + ai * HALF + m * 16; const size_t roff = (size_t)row * ldc + col0;
#pragma unroll
                    for (int bj = 0; bj < 2; ++bj) { const f32x4 pq = *(const PG8_LAS f32x4*)(xch + (ai * HALF + wr * 64 + m * 16 + fr) * 8 + bj * 4);
                        const float r = __builtin_amdgcn_rsqf(((pq[0] + pq[1]) + (pq[2] + pq[3])) * (1.f / 128.f) + 1e-6f);
                        f32x4 v0 = (acc[ai][bj][m][0] * r) * w0, v1 = (acc[ai][bj][m][1] * r) * w1;
                        if (wc == 0) {
                            f32x4 p0, p1;
#pragma unroll
                            for (int e = 0; e < 4; ++e) {
                                const auto t0 = __builtin_amdgcn_permlane32_swap(__float_as_uint(v0[e]), __float_as_uint(v0[e]), false, false);
                                const auto t1 = __builtin_amdgcn_permlane32_swap(__float_as_uint(v1[e]), __float_as_uint(v1[e]), false, false);
                                const unsigned a0 = t0[0], b0 = t0[1], a1 = t1[0], b1 = t1[1];
                                p0[e] = __uint_as_float(fq < 2 ? b0 : a0); p1[e] = __uint_as_float(fq < 2 ? b1 : a1); }
                            v0 = v0 * c0 + p0 * (s0 * sgn); v1 = v1 * c1 + p1 * (s1 * sgn); }
                        u32x4 w; w.x = cvt_pk_bf16(v0[0], v0[1]); w.y = cvt_pk_bf16(v0[2], v0[3]); w.z = cvt_pk_bf16(v1[0], v1[1]); w.w = cvt_pk_bf16(v1[2], v1[3]);
                        *(u32x4*)(O + roff + bj * HALF) = w; }
                    if (wc == 0 && !(ai == 1 && m == 3)) {
#pragma unroll
                        for (int st = 0; st < 5; ++st) if (st == 0 || m == 3) { const f32x4 nc0 = c0 * cd[0] - s0 * sd[0], ns0 = s0 * cd[0] + c0 * sd[0], nc1 = c1 * cd[1] - s1 * sd[1], ns1 = s1 * cd[1] + c1 * sd[1]; c0 = nc0; s0 = ns0; c1 = nc1; s1 = ns1; } } } }
            return;
        }
#pragma unroll
        for (int ai = 0; ai < 2; ++ai) {
            u32x4 s1v[4][2], s2v[4][2];
            if (MODE >= 2) {
#pragma unroll
                for (int m = 0; m < 4; ++m)
#pragma unroll
                    for (int bj = 0; bj < 2; ++bj) { const size_t ro = (size_t)(row0 + ai * HALF + m * 16) * ldc + col0 + bj * HALF;
                        s1v[m][bj] = *(const u32x4*)(S1 + ro); if (MODE == 3) s2v[m][bj] = *(const u32x4*)(S2 + ro); } }
#pragma unroll
            for (int m = 0; m < 4; ++m) { const size_t roff = (size_t)(row0 + ai * HALF + m * 16) * ldc + col0;
#pragma unroll
                for (int bj = 0; bj < 2; ++bj) { f32x4 v0 = acc[ai][bj][m][0], v1 = acc[ai][bj][m][1];
                    if (MODE == 1) {
#pragma unroll
                        for (int e = 0; e < 4; ++e) { v0[e] = sigmoidf_(v0[e]); v1[e] = sigmoidf_(v1[e]); } }
                    if (MODE >= 2) { const u32x4 s = s1v[m][bj];
                        v0[0] *= bf_lo(s.x); v0[1] *= bf_hi(s.x); v0[2] *= bf_lo(s.y); v0[3] *= bf_hi(s.y); v1[0] *= bf_lo(s.z); v1[1] *= bf_hi(s.z); v1[2] *= bf_lo(s.w); v1[3] *= bf_hi(s.w); }
                    if (MODE == 3) { const u32x4 s = s2v[m][bj];
                        v0[0] += bf_lo(s.x); v0[1] += bf_hi(s.x); v0[2] += bf_lo(s.y); v0[3] += bf_hi(s.y); v1[0] += bf_lo(s.z); v1[1] += bf_hi(s.z); v1[2] += bf_lo(s.w); v1[3] += bf_hi(s.w); }
                    u32x4 w; w.x = cvt_pk_bf16(v0[0], v0[1]); w.y = cvt_pk_bf16(v0[2], v0[3]); w.z = cvt_pk_bf16(v1[0], v1[1]); w.w = cvt_pk_bf16(v1[2], v1[3]);
                    *(u32x4*)(O + roff + bj * HALF) = w;
                    if (MODE == 0 && m == 3) { if (halo && u.pn < 6 && fr >= 13) *(u32x4*)(halo + ((size_t)((row0 + ai * HALF + 48) >> 6) * 3 + (fr - 13)) * 1536 + col0 + bj * HALF) = w; } } } }
    }
};
struct EpiRes {
    static constexpr bool PERM = false, AFTER_DRAIN = false;
    const float* base; float* out; int ldc;
    __device__ __forceinline__ void operator()(const f32x4 (&acc)[2][2][4][2], const Unit& u, int wr, int wc, int fr, int fq) const {
        const int row0 = u.pm * BM + wr * 64 + fr, col0 = u.pn * BM + wc * 32 + 4 * fq;
#pragma unroll
        for (int ai = 0; ai < 2; ++ai) {
            f32x4 xb[4][2][2];
#pragma unroll
            for (int m = 0; m < 4; ++m)
#pragma unroll
                for (int bj = 0; bj < 2; ++bj)
#pragma unroll
                    for (int n = 0; n < 2; ++n) xb[m][bj][n] = *(const f32x4*)(base + (size_t)(row0 + ai * HALF + m * 16) * ldc + col0 + bj * HALF + n * 16);
#pragma unroll
            for (int m = 0; m < 4; ++m) { const size_t roff = (size_t)(row0 + ai * HALF + m * 16) * ldc + col0;
#pragma unroll
                for (int bj = 0; bj < 2; ++bj)
#pragma unroll
                    for (int n = 0; n < 2; ++n) *(f32x4*)(out + roff + bj * HALF + n * 16) = acc[ai][bj][m][n] + xb[m][bj][n]; } }
    }
};

template <class Epi, class Sched, bool ALIGN_EPI = false, bool SP2 = false>
__device__ __forceinline__ void gemm_phase(PG8_LAS unsigned char* lds, const Gemm g, const Sched& S, const Epi& E) {
    const int tid = threadIdx.x, wid = __builtin_amdgcn_readfirstlane(tid >> 6), lane = tid & 63, wr = wid >> 2, wc = wid & 3, fr = lane & 15, fq = lane >> 4;
    const int K = g.K, nt = K / BK;
    unsigned voffA[2], voffB[2];
#pragma unroll
    for (int i = 0; i < 2; ++i) { int R, C; stage_rc(tid * 16 + i * 8192, R, C); const int Rb = Epi::PERM ? ((R & ~31) + perm32(R & 31)) : R;
        voffA[i] = (unsigned)(R * g.lda + C) * 2u; voffB[i] = (unsigned)(Rb * g.ldb + C) * 2u; }
    const size_t kstep = (size_t)(BK * 2);
    const size_t hstepA = (size_t)HALF * g.lda * 2, hstepB = (size_t)HALF * g.ldb * 2;
    const size_t tstepA = 2 * hstepA, tstepB = 2 * hstepB;
    const unsigned ldsw = (unsigned)wid * 1024u;
    const int aoff = lds_byte(wr * 64 + fr, fq * 8), boff = lds_byte(wc * 32 + fr, fq * 8);
#define PG8_SA(b, h) (((b) * 2 + (h)) * HTB)
#define PG8_SB(b, h) ((4 + (b) * 2 + (h)) * HTB)
#define PG8_STAGE(bufoff, gbase, voff) do { _Pragma("unroll") for (int _i = 0; _i < 2; ++_i) \
        __builtin_amdgcn_global_load_lds((const unsigned*)((const char*)(gbase) + (voff)[_i]), (PG8_LAS unsigned*)(lds + (bufoff) + ldsw + _i * 8192), 16, 0, 0); } while (0)
#define PG8_LDA(dst, b, h) do { _Pragma("unroll") for (int m = 0; m < 4; ++m) _Pragma("unroll") for (int k = 0; k < 2; ++k) dst[m][k] = *(const PG8_LAS bf16x8*)(lds + PG8_SA(b, h) + aoff + m * 2048 + k * 1024); } while (0)
#define PG8_LDB(dst, b, h) do { _Pragma("unroll") for (int n = 0; n < 2; ++n) _Pragma("unroll") for (int k = 0; k < 2; ++k) dst[n][k] = *(const PG8_LAS bf16x8*)(lds + PG8_SB(b, h) + boff + n * 2048 + k * 1024); } while (0)
#define PG8_MMA(ai, bj, At, Bt) do { __builtin_amdgcn_s_setprio(1); _Pragma("unroll") for (int m = 0; m < 4; ++m) _Pragma("unroll") for (int n = 0; n < 2; ++n) _Pragma("unroll") for (int k = 0; k < 2; ++k) \
        acc[ai][bj][m][n] = __builtin_amdgcn_mfma_f32_16x16x32_bf16(Bt[n][k], At[m][k], acc[ai][bj][m][n], 0, 0, 0); __builtin_amdgcn_s_setprio(0); } while (0)
#define PG8_WAIT_V(n) asm volatile("s_waitcnt vmcnt(" #n ")" ::: "memory")
#define PG8_WAIT_L(n) asm volatile("s_waitcnt lgkmcnt(" #n ")" ::: "memory")
#define PG8_BAR __builtin_amdgcn_s_barrier()
#define PG8_SCHED __builtin_amdgcn_sched_barrier(0)
    Unit cur, nxt; int ui = 0;
    if (!S.next(0, cur)) return;
    f32x4 acc[2][2][4][2];
#pragma unroll
    for (int a = 0; a < 2; ++a)
#pragma unroll
        for (int b = 0; b < 2; ++b)
#pragma unroll
            for (int m = 0; m < 4; ++m)
#pragma unroll
                for (int n = 0; n < 2; ++n) acc[a][b][m][n] = (f32x4){0.f, 0.f, 0.f, 0.f};
    bf16x8 At[4][2], B0[2][2], B1[2][2];
    const char* cA = (const char*)g.A + (size_t)cur.pm * tstepA; const char* cB = (const char*)g.Bt + (size_t)cur.pn * tstepB;
    S.a_ready(cur);
    if constexpr (SP2) {
        PG8_STAGE(PG8_SB(0, 0), cB, voffB); PG8_STAGE(PG8_SB(0, 1), cB + hstepB, voffB); PG8_STAGE(PG8_SA(0, 0), cA, voffA); PG8_STAGE(PG8_SA(0, 1), cA + hstepA, voffA);
        if (wr == 1) PG8_BAR;
        PG8_WAIT_V(2); PG8_BAR;
        PG8_STAGE(PG8_SB(1, 0), cB + kstep, voffB); PG8_STAGE(PG8_SA(1, 0), cA + kstep, voffA); PG8_STAGE(PG8_SB(1, 1), cB + hstepB + kstep, voffB);
        PG8_WAIT_V(6); PG8_BAR;
    } else {
        PG8_STAGE(PG8_SB(0, 0), cB, voffB); PG8_STAGE(PG8_SA(0, 0), cA, voffA); PG8_STAGE(PG8_SB(0, 1), cB + hstepB, voffB); PG8_STAGE(PG8_SA(0, 1), cA + hstepA, voffA);
        if (wr == 1) PG8_BAR;
        PG8_WAIT_V(4); PG8_BAR;
        PG8_STAGE(PG8_SB(1, 0), cB + kstep, voffB); PG8_STAGE(PG8_SA(1, 0), cA + kstep, voffA); PG8_STAGE(PG8_SB(1, 1), cB + hstepB + kstep, voffB);
        PG8_WAIT_V(6); PG8_BAR;
    }
    for (;;) {
        const bool has_next = S.next(ui + 1, nxt);
        const char* nA = has_next ? (const char*)g.A + (size_t)nxt.pm * tstepA : cA; const char* nB = has_next ? (const char*)g.Bt + (size_t)nxt.pn * tstepB : cB;
        for (int t = 0; t < nt; t += 2) {
            const bool last = (t == nt - 2);
            const char* a1 = cA + (size_t)(t + 1) * kstep;
            const char* a2 = last ? nA : cA + (size_t)(t + 2) * kstep; const char* b2 = last ? nB : cB + (size_t)(t + 2) * kstep;
            const char* a3 = a2 + kstep; const char* b3 = b2 + kstep;
            if (last && has_next) S.a_ready(nxt);
            if constexpr (SP2) {
            PG8_LDB(B0, 0, 0); PG8_LDB(B1, 0, 1); PG8_SCHED; PG8_LDA(At, 0, 0); PG8_STAGE(PG8_SA(1, 1), a1 + hstepA, voffA);
            PG8_WAIT_V(8); PG8_WAIT_L(0); PG8_BAR; PG8_MMA(0, 0, At, B0); PG8_MMA(0, 1, At, B1); PG8_BAR; PG8_SCHED;
            PG8_LDA(At, 0, 1); PG8_STAGE(PG8_SB(0, 0), b2, voffB); PG8_STAGE(PG8_SB(0, 1), b2 + hstepB, voffB); PG8_STAGE(PG8_SA(0, 0), a2, voffA);
            PG8_WAIT_V(8); PG8_WAIT_L(0); PG8_BAR; PG8_MMA(1, 0, At, B0); PG8_MMA(1, 1, At, B1); PG8_BAR; PG8_SCHED;
            PG8_LDB(B0, 1, 0); PG8_LDB(B1, 1, 1); PG8_SCHED; PG8_LDA(At, 1, 0); PG8_STAGE(PG8_SA(0, 1), a2 + hstepA, voffA);
            PG8_WAIT_V(8); PG8_WAIT_L(0); PG8_BAR; PG8_MMA(0, 0, At, B0); PG8_MMA(0, 1, At, B1); PG8_BAR; PG8_SCHED;
            PG8_LDA(At, 1, 1); PG8_STAGE(PG8_SB(1, 0), b3, voffB); PG8_STAGE(PG8_SB(1, 1), b3 + hstepB, voffB); PG8_STAGE(PG8_SA(1, 0), a3, voffA);
            PG8_WAIT_V(8); PG8_WAIT_L(0); PG8_BAR; PG8_MMA(1, 0, At, B0); PG8_MMA(1, 1, At, B1); PG8_BAR; PG8_SCHED;
            } else {
            PG8_LDB(B0, 0, 0); PG8_SCHED; PG8_LDA(At, 0, 0); PG8_STAGE(PG8_SA(1, 1), a1 + hstepA, voffA);
            PG8_WAIT_L(8); PG8_BAR; PG8_WAIT_L(0); PG8_MMA(0, 0, At, B0); PG8_BAR; PG8_SCHED;
            PG8_LDB(B1, 0, 1); PG8_STAGE(PG8_SB(0, 0), b2, voffB);
            PG8_BAR; PG8_WAIT_L(0); PG8_MMA(0, 1, At, B1); PG8_BAR;
            PG8_LDA(At, 0, 1); PG8_STAGE(PG8_SA(0, 0), a2, voffA);
            PG8_BAR; PG8_WAIT_L(0); PG8_MMA(1, 0, At, B0); PG8_BAR; PG8_SCHED;
            PG8_STAGE(PG8_SB(0, 1), b2 + hstepB, voffB);
            PG8_WAIT_V(6); PG8_BAR; PG8_MMA(1, 1, At, B1); PG8_BAR;
            PG8_LDB(B0, 1, 0); PG8_SCHED; PG8_LDA(At, 1, 0); PG8_STAGE(PG8_SA(0, 1), a2 + hstepA, voffA);
            PG8_WAIT_L(8); PG8_BAR; PG8_WAIT_L(0); PG8_MMA(0, 0, At, B0); PG8_BAR; PG8_SCHED;
            PG8_LDB(B1, 1, 1); PG8_STAGE(PG8_SB(1, 0), b3, voffB);
            PG8_BAR; PG8_WAIT_L(0); PG8_MMA(0, 1, At, B1); PG8_BAR;
            PG8_LDA(At, 1, 1); PG8_STAGE(PG8_SA(1, 0), a3, voffA);
            PG8_BAR; PG8_WAIT_L(0); PG8_MMA(1, 0, At, B0); PG8_BAR; PG8_SCHED;
            PG8_STAGE(PG8_SB(1, 1), b3 + hstepB, voffB);
            PG8_WAIT_V(6); PG8_BAR; PG8_MMA(1, 1, At, B1); PG8_BAR;
            }
        }
        if constexpr (ALIGN_EPI) { if (wr == 0) PG8_BAR; }
        if constexpr (!Epi::AFTER_DRAIN) { E(acc, cur, wr, wc, fr, fq); S.done(cur); }
        if (!has_next) break;
#pragma unroll
        for (int a = 0; a < 2; ++a)
#pragma unroll
            for (int b = 0; b < 2; ++b)
#pragma unroll
                for (int m = 0; m < 4; ++m)
#pragma unroll
                    for (int n = 0; n < 2; ++n) acc[a][b][m][n] = (f32x4){0.f, 0.f, 0.f, 0.f};
        cur = nxt; cA = nA; cB = nB; ++ui;
        if constexpr (ALIGN_EPI) { if (wr == 1) PG8_BAR; }
    }
    PG8_WAIT_V(0);
    if constexpr (!ALIGN_EPI) { if (wr == 0) PG8_BAR; }
    PG8_BAR;
    if constexpr (Epi::AFTER_DRAIN) { E.fused(acc, cur, wr, wc, fr, fq, lds, wid, lane); S.done(cur); }
#undef PG8_SA
#undef PG8_SB
#undef PG8_STAGE
#undef PG8_LDA
#undef PG8_LDB
#undef PG8_MMA
#undef PG8_WAIT_V
#undef PG8_WAIT_L
#undef PG8_BAR
#undef PG8_SCHED
}

struct UnitD { const char* A; const char* B; unsigned lda2, ldb2; int nt, pm, pn, mode; bf16_t* O; const bf16_t* S1; const bf16_t* S2; };
template <class Sched, bool ALIGN_EPI>
__device__ __forceinline__ void gemm_stream(PG8_LAS unsigned char* lds, const Sched& S, int ldc) {
    const int tid = threadIdx.x, wid = __builtin_amdgcn_readfirstlane(tid >> 6), lane = tid & 63, wr = wid >> 2, wc = wid & 3, fr = lane & 15, fq = lane >> 4;
    unsigned RA[2], RB[2], CC[2];
#pragma unroll
    for (int i = 0; i < 2; ++i) { int R, C; stage_rc(tid * 16 + i * 8192, R, C); RA[i] = (unsigned)R; RB[i] = (unsigned)((R & ~31) + perm32(R & 31)); CC[i] = (unsigned)C * 2u; }
    const size_t kstep = (size_t)(BK * 2);
    const unsigned ldsw = (unsigned)wid * 1024u;
    const int aoff = lds_byte(wr * 64 + fr, fq * 8), boff = lds_byte(wc * 32 + fr, fq * 8);
#define PG8_SA(b, h) (((b) * 2 + (h)) * HTB)
#define PG8_SB(b, h) ((4 + (b) * 2 + (h)) * HTB)
#define PG8_STAGE(bufoff, gbase, voff) do { _Pragma("unroll") for (int _i = 0; _i < 2; ++_i) \
        __builtin_amdgcn_global_load_lds((const unsigned*)((const char*)(gbase) + (voff)[_i]), (PG8_LAS unsigned*)(lds + (bufoff) + ldsw + _i * 8192), 16, 0, 0); } while (0)
#define PG8_LDA(dst, b, h) do { _Pragma("unroll") for (int m = 0; m < 4; ++m) _Pragma("unroll") for (int k = 0; k < 2; ++k) dst[m][k] = *(const PG8_LAS bf16x8*)(lds + PG8_SA(b, h) + aoff + m * 2048 + k * 1024); } while (0)
#define PG8_LDB(dst, b, h) do { _Pragma("unroll") for (int n = 0; n < 2; ++n) _Pragma("unroll") for (int k = 0; k < 2; ++k) dst[n][k] = *(const PG8_LAS bf16x8*)(lds + PG8_SB(b, h) + boff + n * 2048 + k * 1024); } while (0)
#define PG8_MMA(ai, bj, At, Bt) do { __builtin_amdgcn_s_setprio(1); _Pragma("unroll") for (int m = 0; m < 4; ++m) _Pragma("unroll") for (int n = 0; n < 2; ++n) _Pragma("unroll") for (int k = 0; k < 2; ++k) \
        acc[ai][bj][m][n] = __builtin_amdgcn_mfma_f32_16x16x32_bf16(Bt[n][k], At[m][k], acc[ai][bj][m][n], 0, 0, 0); __builtin_amdgcn_s_setprio(0); } while (0)
#define PG8_WAIT_V(n) asm volatile("s_waitcnt vmcnt(" #n ")" ::: "memory")
#define PG8_WAIT_L(n) asm volatile("s_waitcnt lgkmcnt(" #n ")" ::: "memory")
#define PG8_BAR __builtin_amdgcn_s_barrier()
#define PG8_SCHED __builtin_amdgcn_sched_barrier(0)
#define PG8_VOFF(vA, vB, u) do { _Pragma("unroll") for (int _i = 0; _i < 2; ++_i) { vA[_i] = RA[_i] * (u).lda2 + CC[_i]; vB[_i] = RB[_i] * (u).ldb2 + CC[_i]; } } while (0)
    UnitD cur, nxt; int ui = 0;
    if (!S.next(0, cur)) return;
    f32x4 acc[2][2][4][2];
#pragma unroll
    for (int a = 0; a < 2; ++a)
#pragma unroll
        for (int b = 0; b < 2; ++b)
#pragma unroll
            for (int m = 0; m < 4; ++m)
#pragma unroll
                for (int n = 0; n < 2; ++n) acc[a][b][m][n] = (f32x4){0.f, 0.f, 0.f, 0.f};
    bf16x8 At[4][2], B0[2][2], B1[2][2];
    unsigned vAc[2], vBc[2], vAn[2], vBn[2];
    PG8_VOFF(vAc, vBc, cur);
    {   const char* cA = cur.A; const char* cB = cur.B; const size_t hA = (size_t)HALF * cur.lda2, hB = (size_t)HALF * cur.ldb2;
        PG8_STAGE(PG8_SB(0, 0), cB, vBc); PG8_STAGE(PG8_SB(0, 1), cB + hB, vBc); PG8_STAGE(PG8_SA(0, 0), cA, vAc); PG8_STAGE(PG8_SA(0, 1), cA + hA, vAc);
        if (wr == 1) PG8_BAR;
        PG8_WAIT_V(2); PG8_BAR;
        PG8_STAGE(PG8_SB(1, 0), cB + kstep, vBc); PG8_STAGE(PG8_SA(1, 0), cA + kstep, vAc); PG8_STAGE(PG8_SB(1, 1), cB + hB + kstep, vBc);
        PG8_WAIT_V(6); PG8_BAR; }
    for (;;) {
        const bool has_next = S.next(ui + 1, nxt);
        if (!has_next) nxt = cur;
        PG8_VOFF(vAn, vBn, nxt);
        const char* cA = cur.A; const char* cB = cur.B; const size_t hAc = (size_t)HALF * cur.lda2, hAn = (size_t)HALF * nxt.lda2, hBn = (size_t)HALF * nxt.ldb2, hBc = (size_t)HALF * cur.ldb2;
        const int nt = cur.nt;
        for (int t = 0; t < nt; t += 2) {
            const bool last = (t == nt - 2);
            const char* a1 = cA + (size_t)(t + 1) * kstep;
            const char* a2 = last ? nxt.A : cA + (size_t)(t + 2) * kstep; const char* b2 = last ? nxt.B : cB + (size_t)(t + 2) * kstep;
            const char* a3 = a2 + kstep; const char* b3 = b2 + kstep;
            unsigned vA2[2], vB2[2];
#pragma unroll
            for (int _i = 0; _i < 2; ++_i) { vA2[_i] = last ? vAn[_i] : vAc[_i]; vB2[_i] = last ? vBn[_i] : vBc[_i]; }
            const size_t hA2 = last ? hAn : hAc, hB2 = last ? hBn : hBc;
            PG8_LDB(B0, 0, 0); PG8_LDB(B1, 0, 1); PG8_SCHED; PG8_LDA(At, 0, 0); PG8_STAGE(PG8_SA(1, 1), a1 + hAc, vAc);
            PG8_WAIT_V(8); PG8_WAIT_L(0); PG8_BAR; PG8_MMA(0, 0, At, B0); PG8_MMA(0, 1, At, B1); PG8_BAR; PG8_SCHED;
            PG8_LDA(At, 0, 1); PG8_STAGE(PG8_SB(0, 0), b2, vB2); PG8_STAGE(PG8_SB(0, 1), b2 + hB2, vB2); PG8_STAGE(PG8_SA(0, 0), a2, vA2);
            PG8_WAIT_V(8); PG8_WAIT_L(0); PG8_BAR; PG8_MMA(1, 0, At, B0); PG8_MMA(1, 1, At, B1); PG8_BAR; PG8_SCHED;
            PG8_LDB(B0, 1, 0); PG8_LDB(B1, 1, 1); PG8_SCHED; PG8_LDA(At, 1, 0); PG8_STAGE(PG8_SA(0, 1), a2 + hA2, vA2);
            PG8_WAIT_V(8); PG8_WAIT_L(0); PG8_BAR; PG8_MMA(0, 0, At, B0); PG8_MMA(0, 1, At, B1); PG8_BAR; PG8_SCHED;
            PG8_LDA(At, 1, 1); PG8_STAGE(PG8_SB(1, 0), b3, vB2); PG8_STAGE(PG8_SB(1, 1), b3 + hB2, vB2); PG8_STAGE(PG8_SA(1, 0), a3, vA2);
            PG8_WAIT_V(8); PG8_WAIT_L(0); PG8_BAR; PG8_MMA(1, 0, At, B0); PG8_MMA(1, 1, At, B1); PG8_BAR; PG8_SCHED;
        }
        if constexpr (ALIGN_EPI) { if (wr == 0) PG8_BAR; }
        { Unit u{cur.pm, cur.pn};
          if (cur.mode == 1) { EpiBf<1> E{cur.O, cur.S1, cur.S2, ldc, nullptr, nullptr, nullptr, nullptr, nullptr}; E(acc, u, wr, wc, fr, fq); }
          else if (cur.mode == 2) { EpiBf<2> E{cur.O, cur.S1, cur.S2, ldc, nullptr, nullptr, nullptr, nullptr, nullptr}; E(acc, u, wr, wc, fr, fq); }
          else { EpiBf<3> E{cur.O, cur.S1, cur.S2, ldc, nullptr, nullptr, nullptr, nullptr, nullptr}; E(acc, u, wr, wc, fr, fq); } }
        if (!has_next) break;
#pragma unroll
        for (int a = 0; a < 2; ++a)
#pragma unroll
            for (int b = 0; b < 2; ++b)
#pragma unroll
                for (int m = 0; m < 4; ++m)
#pragma unroll
                    for (int n = 0; n < 2; ++n) acc[a][b][m][n] = (f32x4){0.f, 0.f, 0.f, 0.f};
        cur = nxt; ++ui;
#pragma unroll
        for (int _i = 0; _i < 2; ++_i) { vAc[_i] = vAn[_i]; vBc[_i] = vBn[_i]; }
        if constexpr (ALIGN_EPI) { if (wr == 1) PG8_BAR; }
    }
    PG8_WAIT_V(0);
    if constexpr (!ALIGN_EPI) { if (wr == 0) PG8_BAR; }
    PG8_BAR;
#undef PG8_SA
#undef PG8_SB
#undef PG8_STAGE
#undef PG8_LDA
#undef PG8_LDB
#undef PG8_MMA
#undef PG8_WAIT_V
#undef PG8_WAIT_L
#undef PG8_BAR
#undef PG8_SCHED
#undef PG8_VOFF
}
}
#define GAS __attribute__((address_space(1)))
#define LAS __attribute__((address_space(3)))
typedef unsigned short bf16;
typedef unsigned v4u __attribute__((ext_vector_type(4)));
typedef float f32x4 __attribute__((ext_vector_type(4)));
typedef short bf16x8 __attribute__((ext_vector_type(8)));
typedef GAS unsigned gu32;
typedef GAS unsigned long long gu64;
#define RLX_AGENT __ATOMIC_RELAXED, __HIP_MEMORY_SCOPE_AGENT
#define LDS_WAIT() asm volatile("s_waitcnt lgkmcnt(0)" ::: "memory")
#define VM_WAIT() asm volatile("s_waitcnt vmcnt(0)" ::: "memory")
__device__ __forceinline__ unsigned long long rt() { return __builtin_amdgcn_s_memrealtime(); }
__device__ __forceinline__ unsigned f2bf(float f) { unsigned u = __builtin_bit_cast(unsigned, f); return (u + 0x7fffu + ((u >> 16) & 1u)) >> 16; }
typedef float f32x2_t __attribute__((ext_vector_type(2))); typedef __bf16 bf16x2_t __attribute__((ext_vector_type(2)));
__device__ __forceinline__ unsigned pk2(float lo, float hi) { const f32x2_t v = {lo, hi}; const bf16x2_t b = __builtin_convertvector(v, bf16x2_t); return __builtin_bit_cast(unsigned, b); }

#define XB_TMO      128
#define XB_XCNT(j)  (256  + 64 * (j))
#define XB_XSUB(j)  (1280 + 64 * (j))
#define XB_XGEN(j)  (2304 + 64 * (j))
#define XB_TOP      3328
#define XB_TOPGEN   3392
#define XCD_BAR_WORDS 3456
#define XB_SPIN_CAP (1u << 22)

__device__ __forceinline__ unsigned xb_ld(unsigned* p)              { return __hip_atomic_load(p, __ATOMIC_RELAXED, __HIP_MEMORY_SCOPE_AGENT); }
__device__ __forceinline__ unsigned xb_add(unsigned* p, unsigned v) { return __hip_atomic_fetch_add(p, v, __ATOMIC_RELAXED, __HIP_MEMORY_SCOPE_AGENT); }
__device__ __forceinline__ unsigned xb_xcc_id() { return (unsigned)__builtin_amdgcn_s_getreg((3 << 11) | 20) & 0xFu; }
#define XB_SPIN(cond, bar) do { unsigned _sp = 0; while (cond) { __builtin_amdgcn_s_sleep(1); \
    if ((++_sp & 255u) == 0u) { if (xb_ld(&(bar)[XB_TMO])) break; if (_sp > XB_SPIN_CAP) { atomicAdd(&(bar)[XB_TMO], 1u); break; } } } } while (0)

struct XcdBarrier {
    unsigned* bar; unsigned x;
    volatile LAS unsigned* st;
};

__device__ __forceinline__ XcdBarrier xcd_barrier_post(unsigned* bar, volatile LAS unsigned* st) {
    XcdBarrier b; b.bar = bar; b.x = xb_xcc_id(); b.st = st;
    if (threadIdx.x == 0) (void)xb_add(&bar[XB_XCNT(b.x)], 1u);
    return b;
}
__device__ __forceinline__ void xcd_barrier_complete(unsigned* bar, unsigned x, unsigned& nloc, unsigned& nx) {
    const unsigned G = gridDim.x * gridDim.y * gridDim.z;
    unsigned sum, cnt, mine, sp = 0u;
    for (;;) {
        sum = 0u; cnt = 0u; mine = 0u;
#pragma unroll
        for (unsigned j = 0; j < 16; ++j) { const unsigned c = xb_ld(&bar[XB_XCNT(j)]); sum += c; cnt += (c > 0u) ? 1u : 0u; mine = (j == x) ? c : mine; }
        if (sum == G) break;
        __builtin_amdgcn_s_sleep(1);
        if ((++sp & 255u) == 0u) { if (xb_ld(&bar[XB_TMO])) break; if (sp > XB_SPIN_CAP) { atomicAdd(&bar[XB_TMO], 1u); break; } }
    }
    nloc = mine > 0u ? mine : 1u; nx = cnt > 0u ? cnt : 1u;
}

__device__ __forceinline__ void xcd_barrier(const XcdBarrier& b) {
    asm volatile("s_waitcnt vmcnt(0)" ::: "memory");
    __syncthreads();
    if (threadIdx.x == 0) {
        unsigned* bar = b.bar;
        __builtin_amdgcn_s_waitcnt(0);
        unsigned nloc = b.st[0], nx = b.st[1];
        if (nloc == 0u) { xcd_barrier_complete(bar, b.x, nloc, nx); b.st[0] = nloc; b.st[1] = nx; }
        const unsigned old = xb_add(&bar[XB_XSUB(b.x)], 1u);
        const unsigned gen = old / nloc;
        if (old + 1u == (gen + 1u) * nloc) {
            __builtin_amdgcn_fence(__ATOMIC_RELEASE, "agent");
            asm volatile("s_waitcnt vmcnt(0)" ::: "memory");
            const unsigned og = xb_add(&bar[XB_TOP], 1u);
            const unsigned tg = og / nx;
            if (og + 1u == (tg + 1u) * nx) xb_add(&bar[XB_TOPGEN], 1u);
            else XB_SPIN(xb_ld(&bar[XB_TOPGEN]) == tg, bar);
            __builtin_amdgcn_fence(__ATOMIC_ACQUIRE, "agent");
            xb_add(&bar[XB_XGEN(b.x)], 1u);
            asm volatile("s_waitcnt vmcnt(0)" ::: "memory");
        } else {
            XB_SPIN(xb_ld(&bar[XB_XGEN(b.x)]) == gen, bar);
            __builtin_amdgcn_fence(__ATOMIC_ACQUIRE, "agent");
            asm volatile("s_waitcnt vmcnt(0)" ::: "memory");
        }
    }
    __syncthreads();
}

constexpr int NWAVES = 8;
constexpr int BATCH = 8, T = 2048, D = 1024, M = BATCH * T;
constexpr int IN_COLS = 9224;
constexpr int NPROJ = 7168;
constexpr int C_DNQ = 0, C_DNK = 512, C_DNV = 1024, C_DNZ = 1536, C_SQ = 2048, C_SK = 3584, C_SV = 5120, C_SZ = 6656;
constexpr float EPS = 1e-6f;
constexpr float QK_SCALE = 0.08838834764831845f;

constexpr size_t MiB = 1u << 20;
constexpr size_t WS_CTL = 0, CTL_ZERO_BYTES = 32768;
constexpr size_t WS_BG = 1 * MiB;
constexpr size_t WS_ROPE = 1 * MiB + 512 * 1024;
constexpr size_t WS_WG = 2 * MiB;
constexpr size_t WS_WDN = 6 * MiB, WS_WSWA = 7 * MiB;
constexpr size_t WS_WOUT = 8 * MiB;
constexpr size_t WS_WIN = 10 * MiB;
constexpr size_t WS_PROJ = 32 * MiB;
constexpr size_t WS_END = 256 * MiB;
static_assert(WS_WIN + (size_t)NPROJ * D * 2 <= WS_PROJ && WS_PROJ + (size_t)M * NPROJ * 2 <= WS_END, "d_ws map");
constexpr size_t OUT_LT = 32 * MiB, OUT_A = 48 * MiB, OUT_HALO = 58 * MiB, OUT_CS = 61 * MiB;
constexpr size_t WS_LSE = 24 * MiB;
constexpr size_t OUT_ODN = 32 * MiB, OUT_OSWA = 48 * MiB;
constexpr size_t PJ_SCR1 = 0, PJ_SCR2 = 32 * MiB, PJ_SCR3 = 64 * MiB, PJ_MERGED = 96 * MiB;
constexpr int CW_BAR = 4096;

constexpr int RING_OFF = 0, RING_BYTES = 147456;
constexpr int LDSCTL_OFF = RING_BYTES, MISC_OFF = LDSCTL_OFF + 320;
constexpr int LDS_BYTES = 163840;


struct Frame {
    LAS unsigned char* lds;
    volatile LAS unsigned* MISC;
    gu32* ctl;
    int tid, lane, wave;
    int vcu, G;
    const float *x, *norm_w, *w_in, *conv_w, *a_log, *dt_bias, *dn_norm_w, *q_norm_w, *k_norm_w, *w_bdn, *w_bswa, *w_out;
    float* out;
    bf16 *WinT, *WgT, *WdnT, *WswaT, *WoutT, *H, *PROJ;
    float* BG; float* ROPE; float* LSE; float* LT; float* CS; bf16* AIMG; bf16* HALO; bf16* ODN; bf16* OSWA;
};
template <int N> __device__ __forceinline__ float row_ror(float v) { return __builtin_bit_cast(float, __builtin_amdgcn_update_dpp(0, __builtin_bit_cast(int, v), 0x120 + N, 0xf, 0xf, true)); }
__device__ __forceinline__ float row16_sum(float v) { v += row_ror<8>(v); v += row_ror<4>(v); v += row_ror<2>(v); v += row_ror<1>(v); return v; }
__device__ __forceinline__ float wave_sum(float v) {
    v = row16_sum(v);
    { const auto t = __builtin_amdgcn_permlane16_swap(__float_as_uint(v), __float_as_uint(v), false, false); v = __uint_as_float(t[0]) + __uint_as_float(t[1]); }
    { const auto t = __builtin_amdgcn_permlane32_swap(__float_as_uint(v), __float_as_uint(v), false, false); v = __uint_as_float(t[0]) + __uint_as_float(t[1]); }
    return v;
}
__device__ __forceinline__ float bf_lo(unsigned w) { return __builtin_bit_cast(float, w << 16); }
__device__ __forceinline__ float bf_hi(unsigned w) { return __builtin_bit_cast(float, w & 0xffff0000u); }
__device__ __forceinline__ float bf2f(bf16 v) { return __builtin_bit_cast(float, (unsigned)v << 16); }
__device__ __forceinline__ float siluf_(float a) { return a * __builtin_amdgcn_rcpf(1.0f + __expf(-a)); }
__device__ __forceinline__ float sigm_(float a) { return __builtin_amdgcn_rcpf(1.0f + __expf(-a)); }

struct TrItem { const float* src; bf16* dst; int ldw, K, k0; };
__device__ __forceinline__ void tr_load(const TrItem& t, float (&tv)[32], int lane) {
#pragma unroll
    for (int i = 0; i < 32; ++i) { const int kk = 2 * i + (lane >> 5); tv[i] = t.src[(size_t)(t.k0 + kk) * t.ldw + (lane & 31)]; }
}
__device__ __forceinline__ void tr_scatter(const float (&tv)[32], LAS float* scr, int lane) {
#pragma unroll
    for (int i = 0; i < 32; ++i) { const int kk = 2 * i + (lane >> 5); scr[kk * 33 + (lane & 31)] = tv[i]; }
    LDS_WAIT(); asm volatile("" ::: "memory");
}
__device__ __forceinline__ void tr_store(const TrItem& t, LAS float* scr, int lane) {
    const int c = lane & 7;
#pragma unroll
    for (int j = 0; j < 4; ++j) { const int n = (lane >> 3) + 8 * j; const LAS float* s = scr + (8 * c) * 33 + n;
        v4u o; o.x = pk2(s[0 * 33], s[1 * 33]); o.y = pk2(s[2 * 33], s[3 * 33]); o.z = pk2(s[4 * 33], s[5 * 33]); o.w = pk2(s[6 * 33], s[7 * 33]);
        *(GAS v4u*)(t.dst + (size_t)n * t.K + t.k0 + 8 * c) = o; }
    LDS_WAIT(); asm volatile("" ::: "memory");
}
constexpr int TR_I_IN = 16 * (NPROJ / 32), TR_I_G = 16 * 64, TR_I_DN = 8 * 32, TR_I_SWA = 8 * 32, TR_I_OUT = 16 * 32, TR_NITEMS = TR_I_IN + TR_I_G + TR_I_DN + TR_I_SWA + TR_I_OUT;
__device__ __forceinline__ TrItem tr_decode(Frame& F, int it) {
    TrItem t; int r = it;
    if (r < TR_I_IN) { const int kb = r / (NPROJ / 32), nb = r % (NPROJ / 32), n0 = nb * 32, sc = n0 < 2048 ? n0 : n0 + 8; t.src = F.w_in + sc; t.ldw = IN_COLS; t.dst = F.WinT + (size_t)n0 * D; t.K = D; t.k0 = kb * 64; return t; } r -= TR_I_IN;
    if (r < TR_I_G) { const int kb = r / 64, nb = r % 64, n0 = nb * 32; t.src = F.w_in + 7176 + n0; t.ldw = IN_COLS; t.dst = F.WgT + (size_t)n0 * D; t.K = D; t.k0 = kb * 64; return t; } r -= TR_I_G;
    if (r < TR_I_DN) { const int kb = r / 32, nb = r % 32, n0 = nb * 32; t.src = F.w_bdn + n0; t.ldw = D; t.dst = F.WdnT + (size_t)n0 * 512; t.K = 512; t.k0 = kb * 64; return t; } r -= TR_I_DN;
    if (r < TR_I_SWA) { const int kb = r / 32, nb = r % 32, n0 = nb * 32; t.src = F.w_bswa + n0; t.ldw = D; t.dst = F.WswaT + (size_t)n0 * 512; t.K = 512; t.k0 = kb * 64; return t; } r -= TR_I_SWA;
    { const int kb = r / 32, nb = r % 32, n0 = nb * 32; t.src = F.w_out + n0; t.ldw = D; t.dst = F.WoutT + (size_t)n0 * D; t.K = D; t.k0 = kb * 64; return t; }
}
__device__ __forceinline__ void tr_run(Frame& F, int lo, int hi, LAS float* scr, int gw, int NGW) {
    const int lane = F.lane;
    if (lo + gw < hi) {
        float tv[32]; TrItem cur = tr_decode(F, lo + gw); tr_load(cur, tv, lane);
        for (int it = lo + gw; it < hi; it += NGW) {
            tr_scatter(tv, scr, lane);
            TrItem nxt = cur; const bool more = it + NGW < hi;
            if (more) { nxt = tr_decode(F, it + NGW); tr_load(nxt, tv, lane); }
            tr_store(cur, scr, lane);
            cur = nxt;
        }
    }
}
__device__ __forceinline__ void p0_prologue(Frame& F) {
    LAS float* scr = (LAS float*)(F.lds + RING_OFF + F.wave * 8704);
    const int gw = F.vcu * NWAVES + F.wave, NGW = F.G * NWAVES, lane = F.lane;
    LAS float* wsm = (LAS float*)(F.lds + RING_OFF + 8 * 8704);
    for (int idx = F.tid; idx < 1024 * 8; idx += NWAVES * 64) { const int k = idx >> 3, j = idx & 7; const float v = F.w_in[(size_t)k * IN_COLS + 2048 + j];
        const int ln = (k & 255) >> 2, e = k & 3, jj = k >> 8, c = jj * 4 + e, half = j >> 2; wsm[((half * 16 + c) * 64 + ln) * 4 + (j & 3)] = v; }
    __syncthreads();
    tr_run(F, 0, TR_I_IN, scr, gw, NGW);
    {
        static constexpr double INVF[16] = {1.0, 0.44036660267178046, 0.19392274474868576, 0.08539710028576561, 0.03760603093086393, 0.016560440080994446, 0.007292664737217109, 0.003211445994752591,
                                            0.001414213562373095, 0.000622772421914596, 0.0002742481756762073, 0.00012076973741146504, 5.318295896944988e-05, 2.341999896140934e-05, 1.031338537721246e-05, 4.5416704806078695e-06};
        for (int gt = F.vcu * (NWAVES * 64) + F.tid; gt < T * 16; gt += F.G * NWAVES * 64) {
            const int pos = gt >> 4, i = gt & 15;
            double a = (double)pos * INVF[i] * 0.15915494309189535;
            a -= __builtin_rint(a);
            const float af = (float)a;
            F.ROPE[gt * 2] = __builtin_amdgcn_cosf(af); F.ROPE[gt * 2 + 1] = __builtin_amdgcn_sinf(af);
        }
    }
    f32x4 xn[4];
    { const GAS f32x4* xr = (const GAS f32x4*)(F.x + (size_t)gw * D) + lane;
#pragma unroll
      for (int j = 0; j < 4; ++j) xn[j] = xr[64 * j]; }
    for (int m = gw; m < M; m += NGW) {
        f32x4 v[4]; float ss = 0.f;
#pragma unroll
        for (int j = 0; j < 4; ++j) { v[j] = xn[j]; ss += (v[j].x * v[j].x + v[j].y * v[j].y) + (v[j].z * v[j].z + v[j].w * v[j].w); }
        if (m + NGW < M) { const GAS f32x4* xr = (const GAS f32x4*)(F.x + (size_t)(m + NGW) * D) + lane;
#pragma unroll
            for (int j = 0; j < 4; ++j) xn[j] = xr[64 * j]; }
        const float rstd = __builtin_amdgcn_rsqf(wave_sum(ss) * (1.f / D) + EPS);
#pragma unroll
        for (int j = 0; j < 4; ++j) { const f32x4 nw = ((const GAS f32x4*)F.norm_w)[lane + 64 * j]; v[j] = (v[j] * rstd) * nw; }
        GAS unsigned long long* o8 = (GAS unsigned long long*)(F.H + (size_t)m * D) + lane;
#pragma unroll
        for (int j = 0; j < 4; ++j) o8[64 * j] = (unsigned long long)pk2(v[j].x, v[j].y) | ((unsigned long long)pk2(v[j].z, v[j].w) << 32);
        f32x4 plo = {0.f, 0.f, 0.f, 0.f}, phi = {0.f, 0.f, 0.f, 0.f};
#pragma unroll
        for (int jj = 0; jj < 4; ++jj)
#pragma unroll
            for (int e = 0; e < 4; ++e) { const int c = jj * 4 + e; const float hv = v[jj][e];
                const f32x4 wlo = *(const LAS f32x4*)(wsm + ((0 * 16 + c) * 64 + lane) * 4), whi = *(const LAS f32x4*)(wsm + ((1 * 16 + c) * 64 + lane) * 4);
                plo += wlo * hv; phi += whi * hv; }
        const float p0 = wave_sum(plo.x), p1 = wave_sum(plo.y), p2 = wave_sum(plo.z), p3 = wave_sum(plo.w), p4 = wave_sum(phi.x), p5 = wave_sum(phi.y), p6 = wave_sum(phi.z), p7 = wave_sum(phi.w);
        float val = p0; val = lane == 1 ? p1 : val; val = lane == 2 ? p2 : val; val = lane == 3 ? p3 : val; val = lane == 4 ? p4 : val; val = lane == 5 ? p5 : val; val = lane == 6 ? p6 : val; val = lane == 7 ? p7 : val;
        if (lane < 8) { const int h = lane & 3; float o;
            if (lane < 4) o = sigm_(val);
            else { const float xx = val + F.dt_bias[h]; const float sp = xx > 20.f ? xx : log1pf(expf(xx)); o = -expf(F.a_log[h]) * sp; }
            F.BG[(size_t)m * 8 + lane] = o; }
    }
}

constexpr float SC2 = QK_SCALE * 1.4426950408889634f;
typedef short v4i16_t __attribute__((ext_vector_type(4)));
__device__ __forceinline__ int offK(int row, int b) { return row * 256 + (b ^ ((row & 15) << 4)); }
__device__ __forceinline__ int offV(int row, int b) { return row * 256 + (b ^ ((row & 7) << 5)); }
__device__ __forceinline__ v4i16_t vtr(const LAS unsigned char* p) { return __builtin_amdgcn_ds_read_tr16_b64_v4i16((LAS v4i16_t*)p); }
struct AttnItem { int b, g, h, r, n, sh; };
__device__ __forceinline__ float xrow_max(float v) {
    { const auto t = __builtin_amdgcn_permlane16_swap(__float_as_uint(v), __float_as_uint(v), false, false); v = fmaxf(__uint_as_float(t[0]), __uint_as_float(t[1])); }
    { const auto t = __builtin_amdgcn_permlane32_swap(__float_as_uint(v), __float_as_uint(v), false, false); v = fmaxf(__uint_as_float(t[0]), __uint_as_float(t[1])); }
    return v; }
__device__ __forceinline__ float xrow_sum(float v) {
    { const auto t = __builtin_amdgcn_permlane16_swap(__float_as_uint(v), __float_as_uint(v), false, false); v = __uint_as_float(t[0]) + __uint_as_float(t[1]); }
    { const auto t = __builtin_amdgcn_permlane32_swap(__float_as_uint(v), __float_as_uint(v), false, false); v = __uint_as_float(t[0]) + __uint_as_float(t[1]); }
    return v; }
__device__ __forceinline__ void attn_stage_half(Frame& F, const AttnItem& a, int hlog, int slot, LAS unsigned char* ldsK, LAS unsigned char* ldsV) {
    const int lane = F.lane, w = F.wave; const size_t rowb = (size_t)a.b * T;
#pragma unroll
    for (int i = 0; i < 4; ++i) { const int p = 4 * w + i, jl = 4 * p + (lane >> 4), s = 128 * (a.n - 1 + hlog) + jl; const int pos = (s << a.sh) + a.r;
        const bf16* rp = F.PROJ + (rowb + pos) * NPROJ + a.g * 512 + a.h * 128; const int pc = lane & 15;
        __builtin_amdgcn_global_load_lds((const unsigned*)(rp + C_SK + ((pc ^ (jl & 15)) * 8)), (LAS unsigned*)(ldsK + slot * 32768 + p * 1024), 16, 0, 0);
        __builtin_amdgcn_global_load_lds((const unsigned*)(rp + C_SV + ((pc ^ ((jl & 7) << 1)) * 8)), (LAS unsigned*)(ldsV + slot * 32768 + p * 1024), 16, 0, 0); }
}
__device__ __forceinline__ void p2_attn_run(Frame& F, int q) {
    const int lane = F.lane, w = F.wave, l15 = lane & 15, g4 = lane >> 4;
    LAS unsigned char* ldsK = F.lds + RING_OFF; LAS unsigned char* ldsV = F.lds + RING_OFF + 65536;
    const int bgh = q >> 1, hf = q & 1;
    AttnItem a; a.g = bgh % 3; { const int bh = bgh / 3; a.h = bh & 3; a.b = bh >> 2; } a.sh = 2 * a.g;
    int par = 0; bool staged = false;
    v4u qn[4];
    { AttnItem a0 = a; const int x0 = hf * 8; a0.r = x0 >> (4 - a.sh); a0.n = x0 & ((16 >> a.sh) - 1);
      const int posq0 = ((128 * a0.n + 16 * w + l15) << a.sh) + a0.r; const bf16* q0 = F.PROJ + ((size_t)a.b * T + posq0) * NPROJ + C_SQ + a.g * 512 + a.h * 128;
#pragma unroll
      for (int kk = 0; kk < 4; ++kk) qn[kk] = *(const GAS v4u*)(q0 + 32 * kk + 8 * g4); }
    for (int k = 0; k < 8; ++k) {
    const int x = hf * 8 + k; a.r = x >> (4 - a.sh); a.n = x & ((16 >> a.sh) - 1);
    const int g = a.g, h = a.h, r = a.r, n = a.n, sh = a.sh;
    const size_t rowb = (size_t)a.b * T;
    if (!staged) { par = 0; if (n > 0) attn_stage_half(F, a, 0, 0, ldsK, ldsV); attn_stage_half(F, a, 1, 1, ldsK, ldsV); }
    AttnItem an = a; bool nxt_one = false;
    if (k < 7) { const int xn = x + 1; an.r = xn >> (4 - a.sh); an.n = xn & ((16 >> a.sh) - 1); nxt_one = (an.n == 0) || (an.r == a.r && an.n == a.n + 1); }
    const int qi = 16 * w + l15, sq = 128 * n + qi, posq = (sq << sh) + r;
    bf16* qrow = F.PROJ + (rowb + posq) * NPROJ + C_SQ + g * 512 + h * 128;
    asm volatile("s_waitcnt vmcnt(0)" ::: "memory");
    __syncthreads();
    pg8::bf16x8 qf[4];
#pragma unroll
    for (int kk = 0; kk < 4; ++kk) qf[kk] = __builtin_bit_cast(pg8::bf16x8, qn[kk]);
    if (k < 7) { const int posqn = ((128 * an.n + qi) << sh) + an.r; const bf16* qr2 = F.PROJ + (rowb + posqn) * NPROJ + C_SQ + g * 512 + h * 128;
#pragma unroll
        for (int kk = 0; kk < 4; ++kk) qn[kk] = *(const GAS v4u*)(qr2 + 32 * kk + 8 * g4); }
    float m = -1e30f, lsum = 0.f;
    f32x4 O[8];
#pragma unroll
    for (int dt = 0; dt < 8; ++dt) O[dt] = (f32x4){0.f, 0.f, 0.f, 0.f};
    const int jb0 = 32 * (w >> 1);
    const int trq = l15 >> 2, trp = l15 & 3;
#pragma unroll
    for (int c = 0; c < 5; ++c) {
        const int jb = jb0 + 32 * c;
        if (c == 4) {
            asm volatile("s_waitcnt lgkmcnt(0)" ::: "memory"); __builtin_amdgcn_s_barrier(); asm volatile("" ::: "memory");
            if (nxt_one) attn_stage_half(F, an, 1, par, ldsK, ldsV);
        }
        if (n == 0 && jb + 31 < 128) continue;
        const int jp = (((jb >> 7) ^ par) << 7) + (jb & 127);
        f32x4 s0 = {0.f, 0.f, 0.f, 0.f}, s1 = {0.f, 0.f, 0.f, 0.f};
        {   pg8::bf16x8 ka[4], kb[4];
#pragma unroll
            for (int kk = 0; kk < 4; ++kk) { ka[kk] = *(const LAS pg8::bf16x8*)(ldsK + offK(jp + l15, 64 * kk + 16 * g4)); kb[kk] = *(const LAS pg8::bf16x8*)(ldsK + offK(jp + 16 + l15, 64 * kk + 16 * g4)); }
            __builtin_amdgcn_sched_barrier(0);
#pragma unroll
            for (int kk = 0; kk < 4; ++kk) { s0 = __builtin_amdgcn_mfma_f32_16x16x32_bf16(ka[kk], qf[kk], s0, 0, 0, 0); s1 = __builtin_amdgcn_mfma_f32_16x16x32_bf16(kb[kk], qf[kk], s1, 0, 0, 0); } }
        float xs[8]; float tmax = -INFINITY;
        if (c == 0 || c == 4) {
#pragma unroll
            for (int e = 0; e < 4; ++e) {
                const int j0 = jb + 4 * g4 + e, j1 = j0 + 16; const int d0 = j0 - qi, d1 = j1 - qi;
                const bool ok0 = d0 >= 0 && d0 <= 128 && (n > 0 || j0 >= 128), ok1 = d1 >= 0 && d1 <= 128 && (n > 0 || j1 >= 128);
                xs[e] = ok0 ? s0[e] * SC2 : -INFINITY; xs[4 + e] = ok1 ? s1[e] * SC2 : -INFINITY;
                tmax = fmaxf(tmax, fmaxf(xs[e], xs[4 + e])); }
        } else {
#pragma unroll
            for (int e = 0; e < 4; ++e) { xs[e] = s0[e] * SC2; xs[4 + e] = s1[e] * SC2; tmax = fmaxf(tmax, fmaxf(xs[e], xs[4 + e])); }
        }
        tmax = xrow_max(tmax);
        const float mn = fmaxf(m, tmax), alpha = __builtin_amdgcn_exp2f(m - mn);
        float ps = 0.f;
#pragma unroll
        for (int e = 0; e < 8; ++e) { xs[e] = __builtin_amdgcn_exp2f(xs[e] - mn); ps += xs[e]; }
        lsum = lsum * alpha + ps;
        if (__builtin_amdgcn_ballot_w64(mn > m) != 0ull) {
#pragma unroll
            for (int dt = 0; dt < 8; ++dt) O[dt] = O[dt] * alpha; }
        m = mn;
        v4u pw; pw.x = pk2(xs[0], xs[1]); pw.y = pk2(xs[2], xs[3]); pw.z = pk2(xs[4], xs[5]); pw.w = pk2(xs[6], xs[7]);
        const pg8::bf16x8 pf = __builtin_bit_cast(pg8::bf16x8, pw);
        const int vr1 = jp + 4 * g4 + trq, vr2 = vr1 + 16;
        v4i16_t tv1[8], tv2[8];
#pragma unroll
        for (int dt = 0; dt < 8; ++dt) { tv1[dt] = vtr(ldsV + offV(vr1, 32 * dt + 8 * trp)); tv2[dt] = vtr(ldsV + offV(vr2, 32 * dt + 8 * trp)); }
#pragma unroll
        for (int dt = 0; dt < 8; ++dt) {
            const pg8::bf16x8 af = {tv1[dt][0], tv1[dt][1], tv1[dt][2], tv1[dt][3], tv2[dt][0], tv2[dt][1], tv2[dt][2], tv2[dt][3]};
            O[dt] = __builtin_amdgcn_mfma_f32_16x16x32_bf16(af, pf, O[dt], 0, 0, 0);
        }
    }
    const float lt = xrow_sum(lsum);
    const float inv = __builtin_amdgcn_rcpf(lt);
#pragma unroll
    for (int dt = 0; dt < 8; ++dt) { const f32x4 o = O[dt] * inv;
        const unsigned long long pk = (unsigned long long)pk2(o[0], o[1]) | ((unsigned long long)pk2(o[2], o[3]) << 32);
        *(GAS unsigned long long*)(qrow + 16 * dt + 4 * g4) = pk; }
    if (g4 == 0) F.LSE[((rowb + posq) * 3 + g) * 4 + h] = m + __builtin_amdgcn_logf(lt);
    if (nxt_one) { staged = true; par ^= 1; }
    else { staged = false; asm volatile("s_waitcnt lgkmcnt(0)" ::: "memory"); __builtin_amdgcn_s_barrier(); asm volatile("" ::: "memory"); }
    }
}
#define PREP_MAP() const int gi_ = (tid - 256) >> 4, unit_ = F.wave < 4 ? tid : (16 + (gi_ >> 1)) * 16 + (tid & 15), nr = F.wave < 4 ? 8 : 4; \
    const int rg = unit_ / 48, rem = unit_ - rg * 48, which = rem >> 4, ch = rem & 15, col = which * 512 + h * 128 + ch * 8, rbase = rg * 8 + (F.wave < 4 ? 0 : 4 * (gi_ & 1))
__device__ __forceinline__ void prepA_load(Frame& F, int item, v4u (&raw)[11], f32x4 (&cw)[4][2], float& gv, float& bt) {
    const int tid = F.tid; const int h = item & 3, cg = item >> 2, n = cg & 31; const size_t row0 = (size_t)cg * 64;
    PREP_MAP();
    if (F.wave == 7) { gv = F.BG[(row0 + F.lane) * 8 + 4 + h]; bt = F.BG[(row0 + F.lane) * 8 + h]; }
    {
#pragma unroll
        for (int j = 0; j < 4; ++j) { cw[j][0] = *(const GAS f32x4*)(F.conv_w + j * 1536 + col); cw[j][1] = *(const GAS f32x4*)(F.conv_w + j * 1536 + col + 4); }
#pragma unroll
        for (int i = 0; i < 11; ++i) if (i < nr + 3) { const int rr = rbase - 3 + i;
            if (rr >= 0) raw[i] = *(const GAS v4u*)(F.PROJ + (row0 + rr) * NPROJ + col);
            else if (n > 0) raw[i] = *(const GAS v4u*)(F.HALO + ((size_t)(cg - 1) * 3 + (rr + 3)) * 1536 + col);
            else raw[i] = (v4u){0u, 0u, 0u, 0u}; }
    }
}
__device__ __forceinline__ void prepA_conv(Frame& F, int item, const v4u (&raw)[11], const f32x4 (&cw)[4][2], float gv, float bt, int buf) {
    const int tid = F.tid, lane = F.lane, w = F.wave; const int h = item & 3, cg = item >> 2; const size_t row0 = (size_t)cg * 64;
    LAS unsigned char* Qi = F.lds + RING_OFF + buf * 33792; LAS unsigned char* Ki = Qi + 16384; LAS float* gcs = (LAS float*)(Ki + 16384); LAS float* bts = gcs + 64;
    PREP_MAP();
    if (w == 7) {
        float x = gv;
#define DPP_ADD(ctrl, rmask) x += __builtin_bit_cast(float, __builtin_amdgcn_update_dpp(0, __builtin_bit_cast(int, x), ctrl, rmask, 0xf, false))
        DPP_ADD(0x111, 0xf); DPP_ADD(0x112, 0xf); DPP_ADD(0x114, 0xf); DPP_ADD(0x118, 0xf); DPP_ADD(0x142, 0xa); DPP_ADD(0x143, 0xc);
#undef DPP_ADD
        const float glast = __builtin_bit_cast(float, __builtin_amdgcn_readlane(__builtin_bit_cast(int, x), 63));
        gcs[lane] = x; bts[lane] = bt;
        float* cs = F.CS + (size_t)item * 256; cs[lane] = __expf(x); cs[64 + lane] = bt; cs[128 + lane] = __expf(glast - x); if (lane == 0) cs[192] = __expf(glast);
    }
    {
#pragma unroll
        for (int r = 0; r < 8; ++r) if (r < nr) {
            float y[8];
#pragma unroll
            for (int e = 0; e < 8; ++e) y[e] = 0.f;
#pragma unroll
            for (int j = 0; j < 4; ++j) { const v4u rv = raw[r + j];
                const float xv[8] = {bf_lo(rv.x), bf_hi(rv.x), bf_lo(rv.y), bf_hi(rv.y), bf_lo(rv.z), bf_hi(rv.z), bf_lo(rv.w), bf_hi(rv.w)};
#pragma unroll
                for (int e = 0; e < 8; ++e) y[e] += cw[j][e >> 2][e & 3] * xv[e]; }
            float ss = 0.f;
#pragma unroll
            for (int e = 0; e < 8; ++e) { y[e] = siluf_(y[e]); ss += y[e] * y[e]; }
            ss = row16_sum(ss);
            const float scl = which == 2 ? 1.f : __builtin_amdgcn_rsqf(ss + EPS) * (which == 0 ? QK_SCALE : 1.f);
            v4u o; o.x = pk2(y[0] * scl, y[1] * scl); o.y = pk2(y[2] * scl, y[3] * scl); o.z = pk2(y[4] * scl, y[5] * scl); o.w = pk2(y[6] * scl, y[7] * scl);
            const int rr = rbase + r;
            *(GAS v4u*)(F.PROJ + (row0 + rr) * NPROJ + col) = o;
            if (which < 2) *(LAS v4u*)((which == 0 ? Qi : Ki) + offK(rr, ch * 16)) = o;
        }
    }
}
__device__ __forceinline__ void prepA_mfma(Frame& F, int item, int buf) {
    const int lane = F.lane, w = F.wave, l15 = lane & 15, g4 = lane >> 4;
    LAS unsigned char* Qi = F.lds + RING_OFF + buf * 33792; LAS unsigned char* Ki = Qi + 16384; LAS float* gcs = (LAS float*)(Ki + 16384); LAS float* bts = gcs + 64;
    const int whichm = w >> 2, wi = w & 3; const LAS unsigned char* Xi = whichm ? Qi : Ki;
    float* Lg = F.LT + (size_t)item * 4096; bf16* Ag = F.AIMG + (size_t)item * 4096;
#define BLK(mt, nt, v) ((mt) | ((nt) << 2) | ((v) << 4))
    const unsigned listL = wi == 0 ? (BLK(3, 3, 1) | BLK(0, 0, 1) << 8 | BLK(1, 0, 1) << 16) : wi == 1 ? (BLK(3, 2, 1) | BLK(1, 1, 1) << 8 | BLK(2, 0, 1) << 16) : wi == 2 ? (BLK(3, 1, 1) | BLK(2, 2, 1) << 8) : (BLK(3, 0, 1) | BLK(2, 1, 1) << 8);
    const unsigned listA = wi == 0 ? (BLK(3, 3, 1) | BLK(0, 0, 1) << 8 | BLK(1, 0, 1) << 16) : wi == 1 ? (BLK(3, 2, 1) | BLK(1, 1, 1) << 8 | BLK(2, 0, 1) << 16) : wi == 2 ? (BLK(3, 1, 1) | BLK(2, 2, 1) << 8 | BLK(0, 1, 1) << 16) : (BLK(3, 0, 1) | BLK(2, 1, 1) << 8 | BLK(2, 3, 1) << 16);
#undef BLK
    const unsigned list = whichm ? listA : listL;
#pragma unroll
    for (int s = 0; s < 3; ++s) {
        const unsigned v = (list >> (8 * s)) & 0xffu; const int mt = v & 3, nt = (v >> 2) & 3;
        if (!(v & 16u)) continue;
        f32x4 acc = {0.f, 0.f, 0.f, 0.f};
        if (nt <= mt) {
#pragma unroll
            for (int kk = 0; kk < 4; ++kk) {
                const pg8::bf16x8 a = *(const LAS pg8::bf16x8*)(Xi + offK(16 * mt + l15, 64 * kk + 16 * g4));
                const pg8::bf16x8 bb = *(const LAS pg8::bf16x8*)(Ki + offK(16 * nt + l15, 64 * kk + 16 * g4));
                acc = __builtin_amdgcn_mfma_f32_16x16x32_bf16(a, bb, acc, 0, 0, 0); } }
        const int cp = 16 * nt + l15; const float gcp = gcs[cp];
#pragma unroll
        for (int e = 0; e < 4; ++e) { const int c = 16 * mt + 4 * g4 + e; const float dec = __expf(gcs[c] - gcp);
            if (whichm == 0) { const float val = (c > cp) ? bts[c] * acc[e] * dec : 0.f; Lg[c * 64 + cp] = val; }
            else { const float val = (c >= cp) ? acc[e] * dec : 0.f; Ag[c * 64 + 32 * (nt >> 1) + 8 * (l15 >> 2) + 4 * (nt & 1) + (l15 & 3)] = (bf16)f2bf(val); } }
    }
}
typedef unsigned v2u __attribute__((ext_vector_type(2)));
__device__ __forceinline__ pg8::bf16x8 packB(const f32x4 a, const f32x4 b) { const v4u r = {pk2(a[0], a[1]), pk2(a[2], a[3]), pk2(b[0], b[1]), pk2(b[2], b[3])}; return __builtin_bit_cast(pg8::bf16x8, r); }
__device__ __forceinline__ pg8::bf16x8 frag2(const LAS unsigned char* p1, const LAS unsigned char* p2) {
    const v2u a = *(const LAS v2u*)p1, b = *(const LAS v2u*)p2; const v4u r = {a.x, a.y, b.x, b.y}; return __builtin_bit_cast(pg8::bf16x8, r); }
__device__ __forceinline__ void dn_prep_B4(Frame& F, int base) {
    const int lane = F.lane, w = F.wave, it4 = w >> 1, p = w & 1, l15 = lane & 15, g4 = lane >> 4;
    const int item = base + it4;
    LAS float* Ls = (LAS float*)(F.lds + RING_OFF + it4 * 24576);
    LAS unsigned char* Tl = F.lds + RING_OFF + it4 * 24576 + 16384;
    { const float* Lg = F.LT + (size_t)item * 4096 + p * 2048;
#pragma unroll
      for (int i = 0; i < 8; ++i) { const f32x4 v = ((const GAS f32x4*)Lg)[i * 64 + lane]; *(LAS f32x4*)(Ls + p * 2048 + (i * 64 + lane) * 4) = v; } }
    asm volatile("s_waitcnt vmcnt(0) lgkmcnt(0)" ::: "memory");
    const int rb0 = 32 * p, rb = rb0 + 16 * (g4 & 1), q4 = l15 >> 2, pq = l15 & 3;
    {
        float Td[16];
#pragma unroll
        for (int i = 0; i < 16; ++i) {
            float a0 = 0.f, a1 = 0.f;
            const LAS float* Lr = Ls + (rb + i) * 64 + rb;
#pragma unroll
            for (int q = 0; q < 4; ++q) if (4 * q < i) { const f32x4 lv = *(const LAS f32x4*)(Lr + 4 * q);
#pragma unroll
                for (int e = 0; e < 4; ++e) if (4 * q + e < i) { if (e & 1) a1 += lv[e] * Td[4 * q + e]; else a0 += lv[e] * Td[4 * q + e]; } }
            Td[i] = ((l15 == i) ? 1.f : 0.f) - (a0 + a1);
        }
        if (g4 < 2) {
#pragma unroll
            for (int j = 0; j < 16; ++j) *(LAS bf16*)(Tl + (rb + j) * 128 + (rb + l15) * 2) = (bf16)f2bf(Td[j]);
            *(LAS v4u*)(Tl + (rb0 + (lane >> 1)) * 128 + (rb0 + 16) * 2 + (lane & 1) * 16) = (v4u){0u, 0u, 0u, 0u};
        }
        *(LAS v4u*)(Tl + (16 * p + (lane >> 2)) * 128 + 64 + (lane & 3) * 16) = (v4u){0u, 0u, 0u, 0u};
    }
    asm volatile("s_waitcnt lgkmcnt(0)" ::: "memory");
    {
        const int gk = g4 & 1; const pg8::bf16x8 zf = {0, 0, 0, 0, 0, 0, 0, 0};
        const LAS float* lr = Ls + (rb0 + 16 + l15) * 64 + rb0 + 8 * gk; const f32x4 x0 = *(const LAS f32x4*)lr, x1 = *(const LAS f32x4*)(lr + 4);
        const v4i16_t t1 = vtr(Tl + (rb0 + 8 * gk + q4) * 128 + (rb0 + 4 * pq) * 2), t2 = vtr(Tl + (rb0 + 8 * gk + 4 + q4) * 128 + (rb0 + 4 * pq) * 2);
        pg8::bf16x8 af = packB(x0, x1), bfr = {t1[0], t1[1], t1[2], t1[3], t2[0], t2[1], t2[2], t2[3]};
        if (g4 >= 2) { af = zf; bfr = zf; }
        const f32x4 X = __builtin_amdgcn_mfma_f32_16x16x32_bf16(af, bfr, (f32x4){0.f, 0.f, 0.f, 0.f}, 0, 0, 0);
        const v2u alo = *(const LAS v2u*)(Tl + (rb0 + 16 + l15) * 128 + (rb0 + 16) * 2 + 8 * g4);
        const v4u a4 = {alo.x, alo.y, 0u, 0u};
        const f32x4 R = __builtin_amdgcn_mfma_f32_16x16x32_bf16(__builtin_bit_cast(pg8::bf16x8, a4), packB(X, (f32x4){0.f, 0.f, 0.f, 0.f}), (f32x4){0.f, 0.f, 0.f, 0.f}, 0, 0, 0);
#pragma unroll
        for (int e = 0; e < 4; ++e) *(LAS bf16*)(Tl + (rb0 + 16 + 4 * g4 + e) * 128 + (rb0 + l15) * 2) = (bf16)f2bf(-R[e]);
    }
    asm volatile("s_waitcnt lgkmcnt(0)" ::: "memory");
    __syncthreads();
    {
        f32x4 X[2][2];
#pragma unroll
        for (int mt = 0; mt < 2; ++mt) { const LAS float* lr = Ls + (32 + 16 * mt + l15) * 64 + 8 * g4; const f32x4 x0 = *(const LAS f32x4*)lr, x1 = *(const LAS f32x4*)(lr + 4);
            const pg8::bf16x8 af = packB(x0, x1);
#pragma unroll
            for (int nt = 0; nt < 2; ++nt) {
                const v4i16_t t1 = vtr(Tl + (8 * g4 + q4) * 128 + (16 * nt + 4 * pq) * 2), t2 = vtr(Tl + (8 * g4 + 4 + q4) * 128 + (16 * nt + 4 * pq) * 2);
                const pg8::bf16x8 bfr = {t1[0], t1[1], t1[2], t1[3], t2[0], t2[1], t2[2], t2[3]};
                X[mt][nt] = __builtin_amdgcn_mfma_f32_16x16x32_bf16(af, bfr, (f32x4){0.f, 0.f, 0.f, 0.f}, 0, 0, 0); } }
        const LAS unsigned char* tr22 = Tl + (32 + 16 * p + l15) * 128 + 64;
        const pg8::bf16x8 a22 = frag2(tr22 + 8 * g4, tr22 + 32 + 8 * g4);
#pragma unroll
        for (int nt = 0; nt < 2; ++nt) { const f32x4 R = __builtin_amdgcn_mfma_f32_16x16x32_bf16(a22, packB(X[0][nt], X[1][nt]), (f32x4){0.f, 0.f, 0.f, 0.f}, 0, 0, 0);
#pragma unroll
            for (int e = 0; e < 4; ++e) *(LAS bf16*)(Tl + (32 + 16 * p + 4 * g4 + e) * 128 + (16 * nt + l15) * 2) = (bf16)f2bf(-R[e]); }
    }
    asm volatile("s_waitcnt lgkmcnt(0)" ::: "memory");
    __syncthreads();
    { unsigned char* Tg = (unsigned char*)F.LT + (size_t)item * 16384;
#pragma unroll
      for (int i = 0; i < 4; ++i) { const int id = (p * 4 + i) * 64 + lane, row = id >> 3, dc = id & 7;
          const LAS unsigned char* s = Tl + row * 128 + (32 * (dc >> 2) + 4 * (dc & 3)) * 2; const v2u lo = *(const LAS v2u*)s, hi = *(const LAS v2u*)(s + 32);
          *(GAS v4u*)(Tg + id * 16) = (v4u){lo.x, lo.y, hi.x, hi.y}; } }
}


__device__ __forceinline__ void dn_scan2(Frame& F, int unit) {
    const int lane = F.lane, w = F.wave, l15 = lane & 15, g4 = lane >> 4, trq = l15 >> 2, trp = l15 & 3;
    const int half = unit & 1, h = (unit >> 1) & 3, b = unit >> 3;
    LAS unsigned char* L = F.lds + RING_OFF;
    constexpr int BUFS = 58368, O_K = 0, O_Q = 16384, O_T = 32768, O_A = 40960, O_V = 49152, O_CS = 57344, O_O = 2 * BUFS;
    const int lw = w - 4;
#define DN_GLDS(gp, ldsoff) __builtin_amdgcn_global_load_lds((const unsigned*)(gp), (LAS unsigned*)(ldsoff), 16, 0, 0)
#define DN_FSWZ(r) ((((r) & 3) << 2) | (((r) >> 2) & 3))
#define DN_LOAD2(m, Bn) do { const int cgm = b * 32 + (m); const size_t rowm = (size_t)cgm * 64; const int itm = cgm * 4 + h; \
        _Pragma("unroll") for (int i = 0; i < 4; ++i) { const int p = lw * 4 + i, kr = 4 * p + (lane >> 4), kc = (lane & 15) ^ DN_FSWZ(kr & 15); \
            const bf16* pk = F.PROJ + (rowm + kr) * NPROJ + h * 128 + kc * 8; DN_GLDS(pk + C_DNK, (Bn) + O_K + p * 1024); DN_GLDS(pk + C_DNQ, (Bn) + O_Q + p * 1024); } \
        _Pragma("unroll") for (int i = 0; i < 2; ++i) { const int p = lw * 2 + i, tr_ = 8 * p + (lane >> 3), tc = (lane & 7) ^ ((tr_ >> 1) & 7); \
            DN_GLDS((const bf16*)((const unsigned char*)F.LT + (size_t)itm * 16384) + tr_ * 64 + tc * 8, (Bn) + O_T + p * 1024); \
            DN_GLDS(F.AIMG + (size_t)itm * 4096 + tr_ * 64 + tc * 8, (Bn) + O_A + p * 1024); \
            DN_GLDS(F.PROJ + (rowm + tr_) * NPROJ + C_DNV + h * 128 + 64 * half + (lane & 7) * 8, (Bn) + O_V + p * 1024); } \
        if (lw == 0) DN_GLDS(F.CS + (size_t)itm * 256 + lane * 4, (Bn) + O_CS); } while (0)
#define DN_STORE_O(m, Ob) do { const size_t rowm = (size_t)(b * 32 + (m)) * 64; \
        _Pragma("unroll") for (int i = 0; i < 2; ++i) { const int id = lw * 128 + i * 64 + lane, rr = id >> 3, cc = id & 7; \
            const v4u ov = *(const LAS v4u*)((Ob) + rr * 128 + cc * 16); *(GAS v4u*)(F.PROJ + (rowm + rr) * NPROJ + C_DNV + h * 128 + 64 * half + cc * 8) = ov; } } while (0)
    f32x4 S[8];
#pragma unroll
    for (int kt = 0; kt < 8; ++kt) S[kt] = (f32x4){0.f, 0.f, 0.f, 0.f};
    if (w >= 4) DN_LOAD2(0, L);
    if (w < 4) __builtin_amdgcn_s_setprio(2);
#pragma unroll 2
    for (int n = 0; n < 32; ++n) {
        asm volatile("s_waitcnt vmcnt(0)" ::: "memory");
        __syncthreads();
        const int cur = n & 1; LAS unsigned char* B = L + cur * BUFS;
        if (w >= 4) {
            if (n > 0) DN_STORE_O(n - 1, L + O_O + (cur ^ 1) * 8192);
            if (n < 31) DN_LOAD2(n + 1, L + (cur ^ 1) * BUFS);
        } else {
            const LAS float* cs = (const LAS float*)(B + O_CS);
            pg8::bf16x8 Sb[4];
#pragma unroll
            for (int kk = 0; kk < 4; ++kk) Sb[kk] = packB(S[2 * kk], S[2 * kk + 1]);
            pg8::bf16x8 Rb[2];
            {   f32x4 KS[4];
#pragma unroll
                for (int mt = 0; mt < 4; ++mt) { KS[mt] = (f32x4){0.f, 0.f, 0.f, 0.f}; const int rb = 16 * mt + l15;
#pragma unroll
                    for (int kk = 0; kk < 4; ++kk)
                        KS[mt] = __builtin_amdgcn_mfma_f32_16x16x32_bf16(*(const LAS pg8::bf16x8*)(B + O_K + rb * 256 + (((4 * kk + g4) ^ DN_FSWZ(l15)) << 4)), Sb[kk], KS[mt], 0, 0, 0); }
#pragma unroll
                for (int mt = 0; mt < 4; ++mt) { const f32x4 eg = *(const LAS f32x4*)(cs + 16 * mt + 4 * g4), bt = *(const LAS f32x4*)(cs + 64 + 16 * mt + 4 * g4);
#pragma unroll
                    for (int e = 0; e < 4; ++e) { const float vf = bf2f(*(const LAS bf16*)(B + O_V + (16 * mt + 4 * g4 + e) * 128 + (16 * w + l15) * 2)); KS[mt][e] = bt[e] * (vf - eg[e] * KS[mt][e]); } }
                Rb[0] = packB(KS[0], KS[1]); Rb[1] = packB(KS[2], KS[3]); }
            pg8::bf16x8 Vb[2], Db[2];
            {   f32x4 VN[4];
#pragma unroll
                for (int mt = 0; mt < 4; ++mt) { VN[mt] = (f32x4){0.f, 0.f, 0.f, 0.f}; const int rb = 16 * mt + l15;
#pragma unroll
                    for (int k2 = 0; k2 < 2; ++k2) if (k2 <= (mt >> 1))
                        VN[mt] = __builtin_amdgcn_mfma_f32_16x16x32_bf16(*(const LAS pg8::bf16x8*)(B + O_T + rb * 128 + (((4 * k2 + g4) ^ ((rb >> 1) & 7)) << 4)), Rb[k2], VN[mt], 0, 0, 0); }
                Vb[0] = packB(VN[0], VN[1]); Vb[1] = packB(VN[2], VN[3]);
                const f32x4 d0 = *(const LAS f32x4*)(cs + 128 + 4 * g4), d1 = *(const LAS f32x4*)(cs + 128 + 16 + 4 * g4), d2 = *(const LAS f32x4*)(cs + 128 + 32 + 4 * g4), d3 = *(const LAS f32x4*)(cs + 128 + 48 + 4 * g4);
                Db[0] = packB(VN[0] * d0, VN[1] * d1); Db[1] = packB(VN[2] * d2, VN[3] * d3); }
            LAS unsigned char* Ob = L + O_O + cur * 8192;
#pragma unroll
            for (int mt = 0; mt < 4; ++mt) { f32x4 qs = {0.f, 0.f, 0.f, 0.f}; const int rb = 16 * mt + l15;
#pragma unroll
                for (int kk = 0; kk < 4; ++kk)
                    qs = __builtin_amdgcn_mfma_f32_16x16x32_bf16(*(const LAS pg8::bf16x8*)(B + O_Q + rb * 256 + (((4 * kk + g4) ^ DN_FSWZ(l15)) << 4)), Sb[kk], qs, 0, 0, 0);
                const f32x4 eg = *(const LAS f32x4*)(cs + 16 * mt + 4 * g4);
                f32x4 oc = eg * qs;
#pragma unroll
                for (int k2 = 0; k2 < 2; ++k2) if (k2 <= (mt >> 1))
                    oc = __builtin_amdgcn_mfma_f32_16x16x32_bf16(*(const LAS pg8::bf16x8*)(B + O_A + rb * 128 + (((4 * k2 + g4) ^ ((rb >> 1) & 7)) << 4)), Vb[k2], oc, 0, 0, 0);
                const unsigned p01 = pk2(oc[0], oc[1]), p23 = pk2(oc[2], oc[3]);
                LAS unsigned char* op = Ob + (16 * mt + 4 * g4) * 128 + (16 * w + l15) * 2;
                *(LAS bf16*)(op) = (bf16)(p01 & 0xffffu); *(LAS bf16*)(op + 128) = (bf16)(p01 >> 16); *(LAS bf16*)(op + 256) = (bf16)(p23 & 0xffffu); *(LAS bf16*)(op + 384) = (bf16)(p23 >> 16); }
            const float EGL = cs[192];
#pragma unroll
            for (int kt = 0; kt < 8; ++kt) { S[kt] = S[kt] * EGL;
#pragma unroll
                for (int k2 = 0; k2 < 2; ++k2) { const int c1 = 32 * k2 + 4 * g4 + trq, c2 = c1 + 16;
                    const v4i16_t t1 = vtr(B + O_K + c1 * 256 + (((4 * (kt >> 1) + trp) ^ DN_FSWZ(c1 & 15)) << 4) + 8 * (kt & 1)), t2 = vtr(B + O_K + c2 * 256 + (((4 * (kt >> 1) + trp) ^ DN_FSWZ(c2 & 15)) << 4) + 8 * (kt & 1));
                    const pg8::bf16x8 af = {t1[0], t1[1], t1[2], t1[3], t2[0], t2[1], t2[2], t2[3]};
                    S[kt] = __builtin_amdgcn_mfma_f32_16x16x32_bf16(af, Db[k2], S[kt], 0, 0, 0); } }
        }
    }
    __builtin_amdgcn_s_setprio(0);
    __syncthreads();
    if (w >= 4) DN_STORE_O(31, L + O_O + 8192);
#undef DN_LOAD2
#undef DN_STORE_O
#undef DN_GLDS
#undef DN_FSWZ
}
__device__ __forceinline__ void p2_post(Frame& F, int widx, int nwv) {
    const int lane = F.lane, h = lane >> 4, ch = lane & 15;
    const f32x4 nw0 = *(const GAS f32x4*)(F.dn_norm_w + ch * 8), nw1 = *(const GAS f32x4*)(F.dn_norm_w + ch * 8 + 4);
    const float nwv_[8] = {nw0.x, nw0.y, nw0.z, nw0.w, nw1.x, nw1.y, nw1.z, nw1.w};
    float l0, l1, l2; v4u a, bq, cq, z, zdn, od;
#define POST_LOAD(row_) do { const bf16* bs_ = F.PROJ + (size_t)(row_) * NPROJ; const float* lp_ = F.LSE + (size_t)(row_) * 12 + h; l0 = lp_[0]; l1 = lp_[4]; l2 = lp_[8]; \
        a = *(const GAS v4u*)(bs_ + C_SQ + h * 128 + ch * 8); bq = *(const GAS v4u*)(bs_ + C_SQ + 512 + h * 128 + ch * 8); cq = *(const GAS v4u*)(bs_ + C_SQ + 1024 + h * 128 + ch * 8); \
        z = *(const GAS v4u*)(bs_ + C_SZ + h * 128 + ch * 8); zdn = *(const GAS v4u*)(bs_ + C_DNZ + h * 128 + ch * 8); od = *(const GAS v4u*)(bs_ + C_DNV + h * 128 + ch * 8); } while (0)
    if (widx < M) POST_LOAD(widx);
    for (int row = widx; row < M; row += nwv) {
        const float mx = fmaxf(l0, fmaxf(l1, l2));
        float w0 = __builtin_amdgcn_exp2f(l0 - mx), w1 = __builtin_amdgcn_exp2f(l1 - mx), w2 = __builtin_amdgcn_exp2f(l2 - mx);
        const float inv = __builtin_amdgcn_rcpf(w0 + w1 + w2); w0 *= inv; w1 *= inv; w2 *= inv;
        const unsigned aa[4] = {a.x, a.y, a.z, a.w}, bb[4] = {bq.x, bq.y, bq.z, bq.w}, cc[4] = {cq.x, cq.y, cq.z, cq.w}, zz[4] = {z.x, z.y, z.z, z.w};
        const unsigned dd[4] = {od.x, od.y, od.z, od.w}, zq[4] = {zdn.x, zdn.y, zdn.z, zdn.w};
        if (row + nwv < M) POST_LOAD(row + nwv);
        unsigned oo[4];
#pragma unroll
        for (int e = 0; e < 4; ++e) {
            const float lo = (w0 * bf_lo(aa[e]) + w1 * bf_lo(bb[e]) + w2 * bf_lo(cc[e])) * siluf_(bf_lo(zz[e]));
            const float hi = (w0 * bf_hi(aa[e]) + w1 * bf_hi(bb[e]) + w2 * bf_hi(cc[e])) * siluf_(bf_hi(zz[e]));
            oo[e] = pk2(lo, hi); }
        float ss = 0.f;
#pragma unroll
        for (int e = 0; e < 4; ++e) { const float x0 = bf_lo(dd[e]), x1 = bf_hi(dd[e]); ss += x0 * x0 + x1 * x1; }
        ss = row16_sum(ss);
        const float rstd = __builtin_amdgcn_rsqf(ss * (1.f / 128.f) + EPS);
        unsigned on[4];
#pragma unroll
        for (int e = 0; e < 4; ++e) on[e] = pk2((bf_lo(dd[e]) * rstd) * nwv_[2 * e] * siluf_(bf_lo(zq[e])), (bf_hi(dd[e]) * rstd) * nwv_[2 * e + 1] * siluf_(bf_hi(zq[e])));
        *(GAS v4u*)(F.OSWA + (size_t)row * 512 + h * 128 + ch * 8) = (v4u){oo[0], oo[1], oo[2], oo[3]};
        *(GAS v4u*)(F.ODN + (size_t)row * 512 + h * 128 + ch * 8) = (v4u){on[0], on[1], on[2], on[3]};
    }
#undef POST_LOAD
}

struct Args { const float* in[12]; float* out; unsigned char* ws; int ph_lo, ph_hi; };
__global__ void __launch_bounds__(NWAVES * 64, 2) fwd_kernel(Args args) {
    extern __shared__ __attribute__((aligned(16))) unsigned char lds[];
    Frame F;
    F.lds = (LAS unsigned char*)lds;
    F.MISC = (volatile LAS unsigned*)(F.lds + MISC_OFF);
    F.tid = threadIdx.x; F.lane = F.tid & 63; F.wave = __builtin_amdgcn_readfirstlane(F.tid >> 6);
    F.G = gridDim.x; { const int bx = blockIdx.x; F.vcu = (F.G % 8 == 0) ? (bx % 8) * (F.G / 8) + bx / 8 : bx; }
    unsigned char* ws = args.ws;
    F.ctl = (gu32*)(ws + WS_CTL);
    F.x = args.in[0]; F.norm_w = args.in[1]; F.w_in = args.in[2]; F.conv_w = args.in[3]; F.a_log = args.in[4]; F.dt_bias = args.in[5]; F.dn_norm_w = args.in[6];
    F.q_norm_w = args.in[7]; F.k_norm_w = args.in[8]; F.w_bdn = args.in[9]; F.w_bswa = args.in[10]; F.w_out = args.in[11]; F.out = args.out;
    F.WinT = (bf16*)(ws + WS_WIN); F.WgT = (bf16*)(ws + WS_WG); F.WdnT = (bf16*)(ws + WS_WDN); F.WswaT = (bf16*)(ws + WS_WSWA); F.WoutT = (bf16*)(ws + WS_WOUT);
    F.H = (bf16*)args.out; F.PROJ = (bf16*)(ws + WS_PROJ); F.BG = (float*)(ws + WS_BG); F.ROPE = (float*)(ws + WS_ROPE); F.LSE = (float*)(ws + WS_LSE); F.ODN = (bf16*)((unsigned char*)args.out + OUT_ODN); F.OSWA = (bf16*)((unsigned char*)args.out + OUT_OSWA);
    F.LT = (float*)((unsigned char*)args.out + OUT_LT); F.CS = (float*)((unsigned char*)args.out + OUT_CS); F.AIMG = (bf16*)((unsigned char*)args.out + OUT_A); F.HALO = (bf16*)((unsigned char*)args.out + OUT_HALO);
    for (int u = F.tid; u < (LDS_BYTES - LDSCTL_OFF) / 4; u += NWAVES * 64) ((LAS unsigned*)(F.lds + LDSCTL_OFF))[u] = 0u;
    __syncthreads();
    XcdBarrier bar = xcd_barrier_post((unsigned*)(F.ctl + CW_BAR), F.MISC + 8);
    const int lo = args.ph_lo, hi = args.ph_hi;
#define IN(k) (lo <= (k) && (k) < hi)
#define BOTH(k) (IN(k) && IN((k) + 1))
#define GRID_BAR() xcd_barrier(bar)

    if (IN(0)) { p0_prologue(F); if (BOTH(0)) GRID_BAR(); }

    if (IN(1)) {
        pg8::Gemm g{F.H, F.WinT, M, NPROJ, D, D, D}; pg8::StaticOrder S; S.init(M, NPROJ, F.G, (int)blockIdx.x);
        pg8::EpiBf<0> E{F.PROJ, nullptr, nullptr, NPROJ, F.HALO, F.q_norm_w, F.k_norm_w, F.ROPE, (LAS float*)(F.lds + 131072)};
        pg8::gemm_phase<pg8::EpiBf<0>, pg8::StaticOrder, true, true>(F.lds + RING_OFF, g, S, E);
        if (BOTH(1)) GRID_BAR();
    }
    if (IN(2)) {
        { const int base = F.vcu * 4;
            v4u raw[11]; f32x4 cw[4][2]; float gv = 0.f, bt = 0.f;
            prepA_load(F, base, raw, cw, gv, bt);
            asm volatile("s_waitcnt vmcnt(0)" ::: "memory");
            __syncthreads();
            prepA_conv(F, base, raw, cw, gv, bt, 0);
            prepA_load(F, base + 1, raw, cw, gv, bt);
#pragma unroll 1
            for (int j = 0; j < 4; ++j) {
                asm volatile("s_waitcnt vmcnt(0)" ::: "memory");
                __syncthreads();
                if (j < 3) { prepA_conv(F, base + j + 1, raw, cw, gv, bt, (j + 1) & 1);
                    if (j < 2) prepA_load(F, base + j + 2, raw, cw, gv, bt); }
                prepA_mfma(F, base + j, j & 1);
            }
            asm volatile("s_waitcnt vmcnt(0)" ::: "memory");
            __syncthreads();
            dn_prep_B4(F, base);
            asm volatile("s_waitcnt vmcnt(0)" ::: "memory");
            __syncthreads();
        }
        if (BOTH(2)) GRID_BAR();
    }
    if (IN(3)) {
        if (F.vcu < 64) dn_scan2(F, F.vcu);
        else { p2_attn_run(F, F.vcu - 64); __syncthreads();
            tr_run(F, TR_I_IN, TR_NITEMS, (LAS float*)(F.lds + RING_OFF + F.wave * 8704), (F.vcu - 64) * NWAVES + F.wave, (F.G - 64) * NWAVES); }
        if (BOTH(3)) GRID_BAR();
    }
    if (IN(4)) { p2_post(F, F.vcu * NWAVES + F.wave, F.G * NWAVES); if (BOTH(4)) GRID_BAR(); }
    if (IN(5)) {
        struct P3Sched { int pm, pn; bool ok; const bf16 *H, *WgT, *WdnT, *WswaT, *ODN, *OSWA; bf16* PJ;
            __device__ __forceinline__ bool next(int i, pg8::UnitD& u) const {
                if (!ok || i >= 4) return false;
                u.pm = pm; u.pn = pn;
                const size_t prow = (size_t)pm * 256; bf16* scr1 = PJ + PJ_SCR1 / 2; bf16* scr2 = PJ + PJ_SCR2 / 2; bf16* scr3 = PJ + PJ_SCR3 / 2; bf16* mrg = PJ + PJ_MERGED / 2;
                if (i == 0)      { u.A = (const char*)(H + prow * D); u.lda2 = D * 2; u.B = (const char*)(WgT + (size_t)pn * 256 * D); u.ldb2 = D * 2; u.nt = 16; u.mode = 1; u.O = scr1; u.S1 = nullptr; u.S2 = nullptr; }
                else if (i == 1) { u.A = (const char*)(ODN + prow * 512); u.lda2 = 512 * 2; u.B = (const char*)(WdnT + (size_t)pn * 256 * 512); u.ldb2 = 512 * 2; u.nt = 8; u.mode = 2; u.O = scr2; u.S1 = scr1; u.S2 = nullptr; }
                else if (i == 2) { u.A = (const char*)(H + prow * D); u.lda2 = D * 2; u.B = (const char*)(WgT + (size_t)(1024 + pn * 256) * D); u.ldb2 = D * 2; u.nt = 16; u.mode = 1; u.O = scr3; u.S1 = nullptr; u.S2 = nullptr; }
                else             { u.A = (const char*)(OSWA + prow * 512); u.lda2 = 512 * 2; u.B = (const char*)(WswaT + (size_t)pn * 256 * 512); u.ldb2 = 512 * 2; u.nt = 8; u.mode = 3; u.O = mrg; u.S1 = scr3; u.S2 = scr2; }
                return true; } };
        pg8::StaticOrder S0; S0.init(M, D, F.G, (int)blockIdx.x); pg8::Unit u0; const bool ok = S0.next(0, u0);
        P3Sched S{u0.pm, u0.pn, ok, F.H, F.WgT, F.WdnT, F.WswaT, F.ODN, F.OSWA, F.PROJ};
        pg8::gemm_stream<P3Sched, true>(F.lds + RING_OFF, S, D);
        if (BOTH(5)) GRID_BAR();
    }
    if (IN(6)) {
        pg8::Gemm g{F.PROJ + PJ_MERGED / 2, F.WoutT, M, D, D, D, D}; pg8::StaticOrder S; S.init(M, D, F.G, (int)blockIdx.x);
        pg8::EpiRes E{F.x, F.out, D};
        pg8::gemm_phase<pg8::EpiRes, pg8::StaticOrder, false, true>(F.lds + RING_OFF, g, S, E);
    }
#undef IN
#undef BOTH
#undef GRID_BAR
}

#ifndef N_LAUNCHES
#define N_LAUNCHES 1
#endif
extern "C" void kernel_launch(void* const* d_in, const int* in_sizes, int n_in, void* d_out, int out_size, void* d_ws, size_t ws_size, hipStream_t stream) {
    static int grid = 0;
    if (grid == 0) {
        if (n_in != 12 || in_sizes[0] != M * D || out_size != M * D || ws_size < WS_END) { fprintf(stderr, "kernel_launch: unexpected shapes (n_in %d, in0 %d, out %d, ws %zu); nothing launched\n", n_in, n_in > 0 ? in_sizes[0] : -1, out_size, ws_size); grid = -1; return; }
        int dev = 0, cus = 0, per_cu = 0;
        if (hipGetDevice(&dev) != hipSuccess || hipDeviceGetAttribute(&cus, hipDeviceAttributeMultiprocessorCount, dev) != hipSuccess) { grid = -1; return; }
        if (hipFuncSetAttribute((const void*)fwd_kernel, hipFuncAttributeMaxDynamicSharedMemorySize, LDS_BYTES) != hipSuccess) { fprintf(stderr, "kernel_launch: hipFuncSetAttribute failed\n"); grid = -1; return; }
        if (hipOccupancyMaxActiveBlocksPerMultiprocessor(&per_cu, (const void*)fwd_kernel, NWAVES * 64, LDS_BYTES) != hipSuccess || per_cu < 1) { fprintf(stderr, "kernel_launch: occupancy query says %d blocks per CU; nothing launched\n", per_cu); (void)hipGetLastError(); grid = -1; return; }
        if (cus != 256) { fprintf(stderr, "kernel_launch: built for a 256-CU device (got %d); nothing launched\n", cus); grid = -1; return; }
        grid = cus;
    }
    if (grid < 0) return;
    (void)hipMemsetAsync((char*)d_ws + WS_CTL, 0, CTL_ZERO_BYTES, stream);
    Args a{};
    for (int i = 0; i < 12; ++i) a.in[i] = (const float*)d_in[i];
    a.out = (float*)d_out; a.ws = (unsigned char*)d_ws;
    constexpr int NPH = 7;
#if N_LAUNCHES == 1
    a.ph_lo = 0; a.ph_hi = NPH;
    hipLaunchKernelGGL(fwd_kernel, dim3(grid), dim3(NWAVES * 64), LDS_BYTES, stream, a);
#else
    for (int p = 0; p < NPH; ++p) { a.ph_lo = p; a.ph_hi = p + 1; hipLaunchKernelGGL(fwd_kernel, dim3(grid), dim3(NWAVES * 64), LDS_BYTES, stream, a); }
#endif
}
```

```cpp
#include <hip/hip_runtime.h>
#include <cstdio>
#include <cstdint>
namespace pg8 {
#define PG8_LAS __attribute__((address_space(3)))
typedef unsigned short bf16_t;
typedef short bf16x8 __attribute__((ext_vector_type(8)));
typedef float f32x4 __attribute__((ext_vector_type(4)));
typedef unsigned u32x4 __attribute__((ext_vector_type(4)));
constexpr int BM = 256, BK = 64, HALF = 128, HTB = HALF * BK * 2  , STAGE_BYTES = 8 * HTB, NXCD = 8, WGM = 4;

__host__ __device__ __forceinline__ int lds_byte(int r, int c) { const int st = (r >> 4) * 2 + (c >> 5), rr = r & 15, cc = c & 31, ob = rr * 64 + cc * 2; return st * 1024 + (ob ^ (((ob >> 9) & 1) << 5)); }
__host__ __device__ __forceinline__ void stage_rc(int b, int& R, int& C) { const int st = b / 1024, sb = b % 1024, swz = sb ^ (((sb >> 9) & 1) << 5); R = (st >> 1) * 16 + swz / 64; C = (st & 1) * 32 + (swz % 64) / 2; }
__host__ __device__ __forceinline__ int perm32(int rho) { const int n = rho >> 4, i = rho & 15; return 8 * (i >> 2) + 4 * n + (i & 3); }

struct Unit { int pm, pn; };
struct Gemm { const bf16_t* A; const bf16_t* Bt; int M, N, K, lda, ldb; };

struct StaticOrder {
    int nM, nN, nwg, G, c;
    __host__ __device__ void init(int M, int N, int G_, int c_) { nM = M / BM; nN = N / BM; nwg = nM * nN; G = G_; c = c_; }
    __host__ __device__ bool next(int i, Unit& u) const {
        const long L = (long)i * G + c; if (L >= nwg) return false;
        int wgid = (int)L; { const int q = nwg / NXCD, r = nwg % NXCD, xcd = wgid % NXCD, off = wgid / NXCD; wgid = (xcd < r ? xcd * (q + 1) : r * (q + 1) + (xcd - r) * q) + off; }
        const int nig = WGM * nN, gid = wgid / nig, fm = gid * WGM, gsz = (nM - fm) < WGM ? (nM - fm) : WGM;
        u.pm = fm + ((wgid % nig) % gsz); u.pn = (wgid % nig) / gsz; return true;
    }
    __device__ __forceinline__ void a_ready(const Unit&) const {}
    __device__ __forceinline__ void done(const Unit&) const {}
};

typedef float f32x2_t __attribute__((ext_vector_type(2))); typedef __bf16 bf16x2_t __attribute__((ext_vector_type(2)));
__device__ __forceinline__ unsigned cvt_pk_bf16(float lo, float hi) { const f32x2_t v = {lo, hi}; const bf16x2_t b = __builtin_convertvector(v, bf16x2_t); return __builtin_bit_cast(unsigned, b); }
__device__ __forceinline__ float bf_lo(unsigned w) { return __builtin_bit_cast(float, w << 16); }
__device__ __forceinline__ float bf_hi(unsigned w) { return __builtin_bit_cast(float, w & 0xffff0000u); }
__device__ __forceinline__ float sigmoidf_(float x) { return __builtin_amdgcn_rcpf(1.0f + __expf(-x)); }

template <int MODE> struct EpiBf {
    static constexpr bool PERM = true, AFTER_DRAIN = false;
    bf16_t* O; const bf16_t* S1; const bf16_t* S2; int ldc; bf16_t* halo;
    const float* qnw; const float* knw; const float* rope; PG8_LAS float* xch;
    __device__ __forceinline__ void operator()(const f32x4 (&acc)[2][2][4][2], const Unit& u, int wr, int wc, int fr, int fq) const {
        const int row0 = u.pm * BM + wr * 64 + fr; const int col0 = u.pn * BM + wc * 32 + 8 * fq;
        if (MODE == 0 && qnw != nullptr && u.pn >= 8 && u.pn < 20) {
            const int which = u.pn >= 14 ? 1 : 0, g = (u.pn - (which ? 14 : 8)) >> 1;
#pragma unroll
            for (int ai = 0; ai < 2; ++ai)
#pragma unroll
                for (int m = 0; m < 4; ++m)
#pragma unroll
                    for (int bj = 0; bj < 2; ++bj) { const f32x4 v0 = acc[ai][bj][m][0], v1 = acc[ai][bj][m][1];
                        float s = (v0[0] * v0[0] + v0[1] * v0[1]) + (v0[2] * v0[2] + v0[3] * v0[3]) + (v1[0] * v1[0] + v1[1] * v1[1]) + (v1[2] * v1[2] + v1[3] * v1[3]);
                        { const auto t = __builtin_amdgcn_permlane16_swap(__float_as_uint(s), __float_as_uint(s), false, false); s = __uint_as_float(t[0]) + __uint_as_float(t[1]); }
                        { const auto t = __builtin_amdgcn_permlane32_swap(__float_as_uint(s), __float_as_uint(s), false, false); s = __uint_as_float(t[0]) + __uint_as_float(t[1]); }
                        if (fq == 0) xch[(ai * HALF + wr * 64 + m * 16 + fr) * 8 + bj * 4 + wc] = s; }
            asm volatile("s_waitcnt lgkmcnt(0)" ::: "memory"); __builtin_amdgcn_s_barrier(); asm volatile("" ::: "memory");
            const float* nwp = (which ? knw : qnw) + g * 128 + wc * 32 + fq * 8;
            const f32x4 w0 = *(const f32x4*)nwp, w1 = *(const f32x4*)(nwp + 4);
            f32x4 c0 = {1.f, 1.f, 1.f, 1.f}, c1 = c0, s0 = {0.f, 0.f, 0.f, 0.f}, s1 = s0, cd[2], sd[2];
            if (wc == 0) {
                { const f32x4* rp = (const f32x4*)(rope + ((size_t)(row0 & 2047) * 16 + (fq & 1) * 8) * 2); const f32x4 r0 = rp[0], r1 = rp[1], r2 = rp[2], r3 = rp[3];
                    c0 = (f32x4){r0[0], r0[2], r1[0], r1[2]}; c1 = (f32x4){r2[0], r2[2], r3[0], r3[2]}; s0 = (f32x4){r0[1], r0[3], r1[1], r1[3]}; s1 = (f32x4){r2[1], r2[3], r3[1], r3[3]}; }
                { const f32x4* rp = (const f32x4*)(rope + ((size_t)16 * 16 + (fq & 1) * 8) * 2); const f32x4 r0 = rp[0], r1 = rp[1], r2 = rp[2], r3 = rp[3];
                    cd[0] = (f32x4){r0[0], r0[2], r1[0], r1[2]}; cd[1] = (f32x4){r2[0], r2[2], r3[0], r3[2]}; sd[0] = (f32x4){r0[1], r0[3], r1[1], r1[3]}; sd[1] = (f32x4){r2[1], r2[3], r3[1], r3[3]}; }
            }
            const float sgn = fq < 2 ? -1.f : 1.f;
#pragma unroll
            for (int ai = 0; ai < 2; ++ai) {
#pragma unroll
                for (int m = 0; m < 4; ++m) { const int row = row0 + ai * HALF + m * 16; const size_t roff = (size_t)row * ldc + col0;
#pragma unroll
                    for (int bj = 0; bj < 2; ++bj) { const f32x4 pq = *(const PG8_LAS f32x4*)(xch + (ai * HALF + wr * 64 + m * 16 + fr) * 8 + bj * 4);
                        const float r = __builtin_amdgcn_rsqf(((pq[0] + pq[1]) + (pq[2] + pq[3])) * (1.f / 128.f) + 1e-6f);
                        f32x4 v0 = (acc[ai][bj][m][0] * r) * w0, v1 = (acc[ai][bj][m][1] * r) * w1;
                        if (wc == 0) {
                            f32x4 p0, p1;
#pragma unroll
                            for (int e = 0; e < 4; ++e) {
                                const auto t0 = __builtin_amdgcn_permlane32_swap(__float_as_uint(v0[e]), __float_as_uint(v0[e]), false, false);
                                const auto t1 = __builtin_amdgcn_permlane32_swap(__float_as_uint(v1[e]), __float_as_uint(v1[e]), false, false);
                                const unsigned a0 = t0[0], b0 = t0[1], a1 = t1[0], b1 = t1[1];
                                p0[e] = __uint_as_float(fq < 2 ? b0 : a0); p1[e] = __uint_as_float(fq < 2 ? b1 : a1); }
                            v0 = v0 * c0 + p0 * (s0 * sgn); v1 = v1 * c1 + p1 * (s1 * sgn); }
                        u32x4 w; w.x = cvt_pk_bf16(v0[0], v0[1]); w.y = cvt_pk_bf16(v0[2], v0[3]); w.z = cvt_pk_bf16(v1[0], v1[1]); w.w = cvt_pk_bf16(v1[2], v1[3]);
                        *(u32x4*)(O + roff + bj * HALF) = w; }
                    if (wc == 0 && !(ai == 1 && m == 3)) {
#pragma unroll
                        for (int st = 0; st < 5; ++st) if (st == 0 || m == 3) { const f32x4 nc0 = c0 * cd[0] - s0 * sd[0], ns0 = s0 * cd[0] + c0 * sd[0], nc1 = c1 * cd[1] - s1 * sd[1], ns1 = s1 * cd[1] + c1 * sd[1]; c0 = nc0; s0 = ns0; c1 = nc1; s1 = ns1; } } } }
            return;
        }
#pragma unroll
        for (int ai = 0; ai < 2; ++ai) {
            u32x4 s1v[4][2], s2v[4][2];
            if (MODE >= 2) {
#pragma unroll
                for (int m = 0; m < 4; ++m)
#pragma unroll
                    for (int bj = 0; bj < 2; ++bj) { const size_t ro = (size_t)(row0 + ai * HALF + m * 16) * ldc + col0 + bj * HALF;
                        s1v[m][bj] = *(const u32x4*)(S1 + ro); if (MODE == 3) s2v[m][bj] = *(const u32x4*)(S2 + ro); } }
#pragma unroll
            for (int m = 0; m < 4; ++m) { const size_t roff = (size_t)(row0 + ai * HALF + m * 16) * ldc + col0;
#pragma unroll
                for (int bj = 0; bj < 2; ++bj) { f32x4 v0 = acc[ai][bj][m][0], v1 = acc[ai][bj][m][1];
                    if (MODE == 1) {
#pragma unroll
                        for (int e = 0; e < 4; ++e) { v0[e] = sigmoidf_(v0[e]); v1[e] = sigmoidf_(v1[e]); } }
                    if (MODE >= 2) { const u32x4 s = s1v[m][bj];
                        v0[0] *= bf_lo(s.x); v0[1] *= bf_hi(s.x); v0[2] *= bf_lo(s.y); v0[3] *= bf_hi(s.y); v1[0] *= bf_lo(s.z); v1[1] *= bf_hi(s.z); v1[2] *= bf_lo(s.w); v1[3] *= bf_hi(s.w); }
                    if (MODE == 3) { const u32x4 s = s2v[m][bj];
                        v0[0] += bf_lo(s.x); v0[1] += bf_hi(s.x); v0[2] += bf_lo(s.y); v0[3] += bf_hi(s.y); v1[0] += bf_lo(s.z); v1[1] += bf_hi(s.z); v1[2] += bf_lo(s.w); v1[3] += bf_hi(s.w); }
                    u32x4 w; w.x = cvt_pk_bf16(v0[0], v0[1]); w.y = cvt_pk_bf16(v0[2], v0[3]); w.z = cvt_pk_bf16(v1[0], v1[1]); w.w = cvt_pk_bf16(v1[2], v1[3]);
                    *(u32x4*)(O + roff + bj * HALF) = w;
                    if (MODE == 0 && m == 3) { if (halo && u.pn < 6 && fr >= 13) *(u32x4*)(halo + ((size_t)((row0 + ai * HALF + 48) >> 6) * 3 + (fr - 13)) * 1536 + col0 + bj * HALF) = w; } } } }
    }
};
struct EpiRes {
    static constexpr bool PERM = false, AFTER_DRAIN = false;
    const float* base; float* out; int ldc;
    __device__ __forceinline__ void operator()(const f32x4 (&acc)[2][2][4][2], const Unit& u, int wr, int wc, int fr, int fq) const {
        const int row0 = u.pm * BM + wr * 64 + fr, col0 = u.pn * BM + wc * 32 + 4 * fq;
#pragma unroll
        for (int ai = 0; ai < 2; ++ai) {
            f32x4 xb[4][2][2];
#pragma unroll
            for (int m = 0; m < 4; ++m)
#pragma unroll
                for (int bj = 0; bj < 2; ++bj)
#pragma unroll
                    for (int n = 0; n < 2; ++n) xb[m][bj][n] = *(const f32x4*)(base + (size_t)(row0 + ai * HALF + m * 16) * ldc + col0 + bj * HALF + n * 16);
#pragma unroll
            for (int m = 0; m < 4; ++m) { const size_t roff = (size_t)(row0 + ai * HALF + m * 16) * ldc + col0;
#pragma unroll
                for (int bj = 0; bj < 2; ++bj)
#pragma unroll
                    for (int n = 0; n < 2; ++n) *(f32x4*)(out + roff + bj * HALF + n * 16) = acc[ai][bj][m][n] + xb[m][bj][n]; } }
    }
};

template <class Epi, class Sched, bool ALIGN_EPI = false, bool SP2 = false>
__device__ __forceinline__ void gemm_phase(PG8_LAS unsigned char* lds, const Gemm g, const Sched& S, const Epi& E) {
    const int tid = threadIdx.x, wid = __builtin_amdgcn_readfirstlane(tid >> 6), lane = tid & 63, wr = wid >> 2, wc = wid & 3, fr = lane & 15, fq = lane >> 4;
    const int K = g.K, nt = K / BK;
    unsigned voffA[2], voffB[2];
#pragma unroll
    for (int i = 0; i < 2; ++i) { int R, C; stage_rc(tid * 16 + i * 8192, R, C); const int Rb = Epi::PERM ? ((R & ~31) + perm32(R & 31)) : R;
        voffA[i] = (unsigned)(R * g.lda + C) * 2u; voffB[i] = (unsigned)(Rb * g.ldb + C) * 2u; }
    const size_t kstep = (size_t)(BK * 2);
    const size_t hstepA = (size_t)HALF * g.lda * 2, hstepB = (size_t)HALF * g.ldb * 2;
    const size_t tstepA = 2 * hstepA, tstepB = 2 * hstepB;
    const unsigned ldsw = (unsigned)wid * 1024u;
    const int aoff = lds_byte(wr * 64 + fr, fq * 8), boff = lds_byte(wc * 32 + fr, fq * 8);
#define PG8_SA(b, h) (((b) * 2 + (h)) * HTB)
#define PG8_SB(b, h) ((4 + (b) * 2 + (h)) * HTB)
#define PG8_STAGE(bufoff, gbase, voff) do { _Pragma("unroll") for (int _i = 0; _i < 2; ++_i) \
        __builtin_amdgcn_global_load_lds((const unsigned*)((const char*)(gbase) + (voff)[_i]), (PG8_LAS unsigned*)(lds + (bufoff) + ldsw + _i * 8192), 16, 0, 0); } while (0)
#define PG8_LDA(dst, b, h) do { _Pragma("unroll") for (int m = 0; m < 4; ++m) _Pragma("unroll") for (int k = 0; k < 2; ++k) dst[m][k] = *(const PG8_LAS bf16x8*)(lds + PG8_SA(b, h) + aoff + m * 2048 + k * 1024); } while (0)
#define PG8_LDB(dst, b, h) do { _Pragma("unroll") for (int n = 0; n < 2; ++n) _Pragma("unroll") for (int k = 0; k < 2; ++k) dst[n][k] = *(const PG8_LAS bf16x8*)(lds + PG8_SB(b, h) + boff + n * 2048 + k * 1024); } while (0)
#define PG8_MMA(ai, bj, At, Bt) do { __builtin_amdgcn_s_setprio(1); _Pragma("unroll") for (int m = 0; m < 4; ++m) _Pragma("unroll") for (int n = 0; n < 2; ++n) _Pragma("unroll") for (int k = 0; k < 2; ++k) \
        acc[ai][bj][m][n] = __builtin_amdgcn_mfma_f32_16x16x32_bf16(Bt[n][k], At[m][k], acc[ai][bj][m][n], 0, 0, 0); __builtin_amdgcn_s_setprio(0); } while (0)
#define PG8_WAIT_V(n) asm volatile("s_waitcnt vmcnt(" #n ")" ::: "memory")
#define PG8_WAIT_L(n) asm volatile("s_waitcnt lgkmcnt(" #n ")" ::: "memory")
#define PG8_BAR __builtin_amdgcn_s_barrier()
#define PG8_SCHED __builtin_amdgcn_sched_barrier(0)
    Unit cur, nxt; int ui = 0;
    if (!S.next(0, cur)) return;
    f32x4 acc[2][2][4][2];
#pragma unroll
    for (int a = 0; a < 2; ++a)
#pragma unroll
        for (int b = 0; b < 2; ++b)
#pragma unroll
            for (int m = 0; m < 4; ++m)
#pragma unroll
                for (int n = 0; n < 2; ++n) acc[a][b][m][n] = (f32x4){0.f, 0.f, 0.f, 0.f};
    bf16x8 At[4][2], B0[2][2], B1[2][2];
    const char* cA = (const char*)g.A + (size_t)cur.pm * tstepA; const char* cB = (const char*)g.Bt + (size_t)cur.pn * tstepB;
    S.a_ready(cur);
    if constexpr (SP2) {
        PG8_STAGE(PG8_SB(0, 0), cB, voffB); PG8_STAGE(PG8_SB(0, 1), cB + hstepB, voffB); PG8_STAGE(PG8_SA(0, 0), cA, voffA); PG8_STAGE(PG8_SA(0, 1), cA + hstepA, voffA);
        if (wr == 1) PG8_BAR;
        PG8_WAIT_V(2); PG8_BAR;
        PG8_STAGE(PG8_SB(1, 0), cB + kstep, voffB); PG8_STAGE(PG8_SA(1, 0), cA + kstep, voffA); PG8_STAGE(PG8_SB(1, 1), cB + hstepB + kstep, voffB);
        PG8_WAIT_V(6); PG8_BAR;
    } else {
        PG8_STAGE(PG8_SB(0, 0), cB, voffB); PG8_STAGE(PG8_SA(0, 0), cA, voffA); PG8_STAGE(PG8_SB(0, 1), cB + hstepB, voffB); PG8_STAGE(PG8_SA(0, 1), cA + hstepA, voffA);
        if (wr == 1) PG8_BAR;
        PG8_WAIT_V(4); PG8_BAR;
        PG8_STAGE(PG8_SB(1, 0), cB + kstep, voffB); PG8_STAGE(PG8_SA(1, 0), cA + kstep, voffA); PG8_STAGE(PG8_SB(1, 1), cB + hstepB + kstep, voffB);
        PG8_WAIT_V(6); PG8_BAR;
    }
    for (;;) {
        const bool has_next = S.next(ui + 1, nxt);
        const char* nA = has_next ? (const char*)g.A + (size_t)nxt.pm * tstepA : cA; const char* nB = has_next ? (const char*)g.Bt + (size_t)nxt.pn * tstepB : cB;
        for (int t = 0; t < nt; t += 2) {
            const bool last = (t == nt - 2);
            const char* a1 = cA + (size_t)(t + 1) * kstep;
            const char* a2 = last ? nA : cA + (size_t)(t + 2) * kstep; const char* b2 = last ? nB : cB + (size_t)(t + 2) * kstep;
            const char* a3 = a2 + kstep; const char* b3 = b2 + kstep;
            if (last && has_next) S.a_ready(nxt);
            if constexpr (SP2) {
            PG8_LDB(B0, 0, 0); PG8_LDB(B1, 0, 1); PG8_SCHED; PG8_LDA(At, 0, 0); PG8_STAGE(PG8_SA(1, 1), a1 + hstepA, voffA);
            PG8_WAIT_V(8); PG8_WAIT_L(0); PG8_BAR; PG8_MMA(0, 0, At, B0); PG8_MMA(0, 1, At, B1); PG8_BAR; PG8_SCHED;
            PG8_LDA(At, 0, 1); PG8_STAGE(PG8_SB(0, 0), b2, voffB); PG8_STAGE(PG8_SB(0, 1), b2 + hstepB, voffB); PG8_STAGE(PG8_SA(0, 0), a2, voffA);
            PG8_WAIT_V(8); PG8_WAIT_L(0); PG8_BAR; PG8_MMA(1, 0, At, B0); PG8_MMA(1, 1, At, B1); PG8_BAR; PG8_SCHED;
            PG8_LDB(B0, 1, 0); PG8_LDB(B1, 1, 1); PG8_SCHED; PG8_LDA(At, 1, 0); PG8_STAGE(PG8_SA(0, 1), a2 + hstepA, voffA);
            PG8_WAIT_V(8); PG8_WAIT_L(0); PG8_BAR; PG8_MMA(0, 0, At, B0); PG8_MMA(0, 1, At, B1); PG8_BAR; PG8_SCHED;
            PG8_LDA(At, 1, 1); PG8_STAGE(PG8_SB(1, 0), b3, voffB); PG8_STAGE(PG8_SB(1, 1), b3 + hstepB, voffB); PG8_STAGE(PG8_SA(1, 0), a3, voffA);
            PG8_WAIT_V(8); PG8_WAIT_L(0); PG8_BAR; PG8_MMA(1, 0, At, B0); PG8_MMA(1, 1, At, B1); PG8_BAR; PG8_SCHED;
            } else {
            PG8_LDB(B0, 0, 0); PG8_SCHED; PG8_LDA(At, 0, 0); PG8_STAGE(PG8_SA(1, 1), a1 + hstepA, voffA);
            PG8_WAIT_L(8); PG8_BAR; PG8_WAIT_L(0); PG8_MMA(0, 0, At, B0); PG8_BAR; PG8_SCHED;
            PG8_LDB(B1, 0, 1); PG8_STAGE(PG8_SB(0, 0), b2, voffB);
            PG8_BAR; PG8_WAIT_L(0); PG8_MMA(0, 1, At, B1); PG8_BAR;
            PG8_LDA(At, 0, 1); PG8_STAGE(PG8_SA(0, 0), a2, voffA);
            PG8_BAR; PG8_WAIT_L(0); PG8_MMA(1, 0, At, B0); PG8_BAR; PG8_SCHED;
            PG8_STAGE(PG8_SB(0, 1), b2 + hstepB, voffB);
            PG8_WAIT_V(6); PG8_BAR; PG8_MMA(1, 1, At, B1); PG8_BAR;
            PG8_LDB(B0, 1, 0); PG8_SCHED; PG8_LDA(At, 1, 0); PG8_STAGE(PG8_SA(0, 1), a2 + hstepA, voffA);
            PG8_WAIT_L(8); PG8_BAR; PG8_WAIT_L(0); PG8_MMA(0, 0, At, B0); PG8_BAR; PG8_SCHED;
            PG8_LDB(B1, 1, 1); PG8_STAGE(PG8_SB(1, 0), b3, voffB);
            PG8_BAR; PG8_WAIT_L(0); PG8_MMA(0, 1, At, B1); PG8_BAR;
            PG8_LDA(At, 1, 1); PG8_STAGE(PG8_SA(1, 0), a3, voffA);
            PG8_BAR; PG8_WAIT_L(0); PG8_MMA(1, 0, At, B0); PG8_BAR; PG8_SCHED;
            PG8_STAGE(PG8_SB(1, 1), b3 + hstepB, voffB);
            PG8_WAIT_V(6); PG8_BAR; PG8_MMA(1, 1, At, B1); PG8_BAR;
            }
        }
        if constexpr (ALIGN_EPI) { if (wr == 0) PG8_BAR; }
        if constexpr (!Epi::AFTER_DRAIN) { E(acc, cur, wr, wc, fr, fq); S.done(cur); }
        if (!has_next) break;
#pragma unroll
        for (int a = 0; a < 2; ++a)
#pragma unroll
            for (int b = 0; b < 2; ++b)
#pragma unroll
                for (int m = 0; m < 4; ++m)
#pragma unroll
                    for (int n = 0; n < 2; ++n) acc[a][b][m][n] = (f32x4){0.f, 0.f, 0.f, 0.f};
        cur = nxt; cA = nA; cB = nB; ++ui;
        if constexpr (ALIGN_EPI) { if (wr == 1) PG8_BAR; }
    }
    PG8_WAIT_V(0);
    if constexpr (!ALIGN_EPI) { if (wr == 0) PG8_BAR; }
    PG8_BAR;
    if constexpr (Epi::AFTER_DRAIN) { E.fused(acc, cur, wr, wc, fr, fq, lds, wid, lane); S.done(cur); }
#undef PG8_SA
#undef PG8_SB
#undef PG8_STAGE
#undef PG8_LDA
#undef PG8_LDB
#undef PG8_MMA
#undef PG8_WAIT_V
#undef PG8_WAIT_L
#undef PG8_BAR
#undef PG8_SCHED
}

struct UnitD { const char* A; const char* B; unsigned lda2, ldb2; int nt, pm, pn, mode; bf16_t* O; const bf16_t* S1; const bf16_t* S2; };
template <class Sched, bool ALIGN_EPI>
__device__ __forceinline__ void gemm_stream(PG8_LAS unsigned char* lds, const Sched& S, int ldc) {
    const int tid = threadIdx.x, wid = __builtin_amdgcn_readfirstlane(tid >> 6), lane = tid & 63, wr = wid >> 2, wc = wid & 3, fr = lane & 15, fq = lane >> 4;
    unsigned RA[2], RB[2], CC[2];
#pragma unroll
    for (int i = 0; i < 2; ++i) { int R, C; stage_rc(tid * 16 + i * 8192, R, C); RA[i] = (unsigned)R; RB[i] = (unsigned)((R & ~31) + perm32(R & 31)); CC[i] = (unsigned)C * 2u; }
    const size_t kstep = (size_t)(BK * 2);
    const unsigned ldsw = (unsigned)wid * 1024u;
    const int aoff = lds_byte(wr * 64 + fr, fq * 8), boff = lds_byte(wc * 32 + fr, fq * 8);
#define PG8_SA(b, h) (((b) * 2 + (h)) * HTB)
#define PG8_SB(b, h) ((4 + (b) * 2 + (h)) * HTB)
#define PG8_STAGE(bufoff, gbase, voff) do { _Pragma("unroll") for (int _i = 0; _i < 2; ++_i) \
        __builtin_amdgcn_global_load_lds((const unsigned*)((const char*)(gbase) + (voff)[_i]), (PG8_LAS unsigned*)(lds + (bufoff) + ldsw + _i * 8192), 16, 0, 0); } while (0)
#define PG8_LDA(dst, b, h) do { _Pragma("unroll") for (int m = 0; m < 4; ++m) _Pragma("unroll") for (int k = 0; k < 2; ++k) dst[m][k] = *(const PG8_LAS bf16x8*)(lds + PG8_SA(b, h) + aoff + m * 2048 + k * 1024); } while (0)
#define PG8_LDB(dst, b, h) do { _Pragma("unroll") for (int n = 0; n < 2; ++n) _Pragma("unroll") for (int k = 0; k < 2; ++k) dst[n][k] = *(const PG8_LAS bf16x8*)(lds + PG8_SB(b, h) + boff + n * 2048 + k * 1024); } while (0)
#define PG8_MMA(ai, bj, At, Bt) do { __builtin_amdgcn_s_setprio(1); _Pragma("unroll") for (int m = 0; m < 4; ++m) _Pragma("unroll") for (int n = 0; n < 2; ++n) _Pragma("unroll") for (int k = 0; k < 2; ++k) \
        acc[ai][bj][m][n] = __builtin_amdgcn_mfma_f32_16x16x32_bf16(Bt[n][k], At[m][k], acc[ai][bj][m][n], 0, 0, 0); __builtin_amdgcn_s_setprio(0); } while (0)
#define PG8_WAIT_V(n) asm volatile("s_waitcnt vmcnt(" #n ")" ::: "memory")
#define PG8_WAIT_L(n) asm volatile("s_waitcnt lgkmcnt(" #n ")" ::: "memory")
#define PG8_BAR __builtin_amdgcn_s_barrier()
#define PG8_SCHED __builtin_amdgcn_sched_barrier(0)
#define PG8_VOFF(vA, vB, u) do { _Pragma("unroll") for (int _i = 0; _i < 2; ++_i) { vA[_i] = RA[_i] * (u).lda2 + CC[_i]; vB[_i] = RB[_i] * (u).ldb2 + CC[_i]; } } while (0)
    UnitD cur, nxt; int ui = 0;
    if (!S.next(0, cur)) return;
    f32x4 acc[2][2][4][2];
#pragma unroll
    for (int a = 0; a < 2; ++a)
#pragma unroll
        for (int b = 0; b < 2; ++b)
#pragma unroll
            for (int m = 0; m < 4; ++m)
#pragma unroll
                for (int n = 0; n < 2; ++n) acc[a][b][m][n] = (f32x4){0.f, 0.f, 0.f, 0.f};
    bf16x8 At[4][2], B0[2][2], B1[2][2];
    unsigned vAc[2], vBc[2], vAn[2], vBn[2];
    PG8_VOFF(vAc, vBc, cur);
    {   const char* cA = cur.A; const char* cB = cur.B; const size_t hA = (size_t)HALF * cur.lda2, hB = (size_t)HALF * cur.ldb2;
        PG8_STAGE(PG8_SB(0, 0), cB, vBc); PG8_STAGE(PG8_SB(0, 1), cB + hB, vBc); PG8_STAGE(PG8_SA(0, 0), cA, vAc); PG8_STAGE(PG8_SA(0, 1), cA + hA, vAc);
        if (wr == 1) PG8_BAR;
        PG8_WAIT_V(2); PG8_BAR;
        PG8_STAGE(PG8_SB(1, 0), cB + kstep, vBc); PG8_STAGE(PG8_SA(1, 0), cA + kstep, vAc); PG8_STAGE(PG8_SB(1, 1), cB + hB + kstep, vBc);
        PG8_WAIT_V(6); PG8_BAR; }
    for (;;) {
        const bool has_next = S.next(ui + 1, nxt);
        if (!has_next) nxt = cur;
        PG8_VOFF(vAn, vBn, nxt);
        const char* cA = cur.A; const char* cB = cur.B; const size_t hAc = (size_t)HALF * cur.lda2, hAn = (size_t)HALF * nxt.lda2, hBn = (size_t)HALF * nxt.ldb2, hBc = (size_t)HALF * cur.ldb2;
        const int nt = cur.nt;
        for (int t = 0; t < nt; t += 2) {
            const bool last = (t == nt - 2);
            const char* a1 = cA + (size_t)(t + 1) * kstep;
            const char* a2 = last ? nxt.A : cA + (size_t)(t + 2) * kstep; const char* b2 = last ? nxt.B : cB + (size_t)(t + 2) * kstep;
            const char* a3 = a2 + kstep; const char* b3 = b2 + kstep;
            unsigned vA2[2], vB2[2];
#pragma unroll
            for (int _i = 0; _i < 2; ++_i) { vA2[_i] = last ? vAn[_i] : vAc[_i]; vB2[_i] = last ? vBn[_i] : vBc[_i]; }
            const size_t hA2 = last ? hAn : hAc, hB2 = last ? hBn : hBc;
            PG8_LDB(B0, 0, 0); PG8_LDB(B1, 0, 1); PG8_SCHED; PG8_LDA(At, 0, 0); PG8_STAGE(PG8_SA(1, 1), a1 + hAc, vAc);
            PG8_WAIT_V(8); PG8_WAIT_L(0); PG8_BAR; PG8_MMA(0, 0, At, B0); PG8_MMA(0, 1, At, B1); PG8_BAR; PG8_SCHED;
            PG8_LDA(At, 0, 1); PG8_STAGE(PG8_SB(0, 0), b2, vB2); PG8_STAGE(PG8_SB(0, 1), b2 + hB2, vB2); PG8_STAGE(PG8_SA(0, 0), a2, vA2);
            PG8_WAIT_V(8); PG8_WAIT_L(0); PG8_BAR; PG8_MMA(1, 0, At, B0); PG8_MMA(1, 1, At, B1); PG8_BAR; PG8_SCHED;
            PG8_LDB(B0, 1, 0); PG8_LDB(B1, 1, 1); PG8_SCHED; PG8_LDA(At, 1, 0); PG8_STAGE(PG8_SA(0, 1), a2 + hA2, vA2);
            PG8_WAIT_V(8); PG8_WAIT_L(0); PG8_BAR; PG8_MMA(0, 0, At, B0); PG8_MMA(0, 1, At, B1); PG8_BAR; PG8_SCHED;
            PG8_LDA(At, 1, 1); PG8_STAGE(PG8_SB(1, 0), b3, vB2); PG8_STAGE(PG8_SB(1, 1), b3 + hB2, vB2); PG8_STAGE(PG8_SA(1, 0), a3, vA2);
            PG8_WAIT_V(8); PG8_WAIT_L(0); PG8_BAR; PG8_MMA(1, 0, At, B0); PG8_MMA(1, 1, At, B1); PG8_BAR; PG8_SCHED;
        }
        if constexpr (ALIGN_EPI) { if (wr == 0) PG8_BAR; }
        { Unit u{cur.pm, cur.pn};
          if (cur.mode == 1) { EpiBf<1> E{cur.O, cur.S1, cur.S2, ldc, nullptr, nullptr, nullptr, nullptr, nullptr}; E(acc, u, wr, wc, fr, fq); }
          else if (cur.mode == 2) { EpiBf<2> E{cur.O, cur.S1, cur.S2, ldc, nullptr, nullptr, nullptr, nullptr, nullptr}; E(acc, u, wr, wc, fr, fq); }
          else { EpiBf<3> E{cur.O, cur.S1, cur.S2, ldc, nullptr, nullptr, nullptr, nullptr, nullptr}; E(acc, u, wr, wc, fr, fq); } }
        if (!has_next) break;
#pragma unroll
        for (int a = 0; a < 2; ++a)
#pragma unroll
            for (int b = 0; b < 2; ++b)
#pragma unroll
                for (int m = 0; m < 4; ++m)
#pragma unroll
                    for (int n = 0; n < 2; ++n) acc[a][b][m][n] = (f32x4){0.f, 0.f, 0.f, 0.f};
        cur = nxt; ++ui;
#pragma unroll
        for (int _i = 0; _i < 2; ++_i) { vAc[_i] = vAn[_i]; vBc[_i] = vBn[_i]; }
        if constexpr (ALIGN_EPI) { if (wr == 1) PG8_BAR; }
    }
    PG8_WAIT_V(0);
    if constexpr (!ALIGN_EPI) { if (wr == 0) PG8_BAR; }
    PG8_BAR;
#undef PG8_SA
#undef PG8_SB
#undef PG8_STAGE
#undef PG8_LDA
#undef PG8_LDB
#undef PG8_MMA
#undef PG8_WAIT_V
#undef PG8_WAIT_L
#undef PG8_BAR
#undef PG8_SCHED
#undef PG8_VOFF
}
}
#define GAS __attribute__((address_space(1)))
#define LAS __attribute__((address_space(3)))
typedef unsigned short bf16;
typedef unsigned v4u __attribute__((ext_vector_type(4)));
typedef float f32x4 __attribute__((ext_vector_type(4)));
typedef short bf16x8 __attribute__((ext_vector_type(8)));
typedef GAS unsigned gu32;
typedef GAS unsigned long long gu64;
#define RLX_AGENT __ATOMIC_RELAXED, __HIP_MEMORY_SCOPE_AGENT
#define LDS_WAIT() asm volatile("s_waitcnt lgkmcnt(0)" ::: "memory")
#define VM_WAIT() asm volatile("s_waitcnt vmcnt(0)" ::: "memory")
__device__ __forceinline__ unsigned long long rt() { return __builtin_amdgcn_s_memrealtime(); }
__device__ __forceinline__ unsigned f2bf(float f) { unsigned u = __builtin_bit_cast(unsigned, f); return (u + 0x7fffu + ((u >> 16) & 1u)) >> 16; }
typedef float f32x2_t __attribute__((ext_vector_type(2))); typedef __bf16 bf16x2_t __attribute__((ext_vector_type(2)));
__device__ __forceinline__ unsigned pk2(float lo, float hi) { const f32x2_t v = {lo, hi}; const bf16x2_t b = __builtin_convertvector(v, bf16x2_t); return __builtin_bit_cast(unsigned, b); }

#define XB_TMO      128
#define XB_XCNT(j)  (256  + 64 * (j))
#define XB_XSUB(j)  (1280 + 64 * (j))
#define XB_XGEN(j)  (2304 + 64 * (j))
#define XB_TOP      3328
#define XB_TOPGEN   3392
#define XCD_BAR_WORDS 3456
#define XB_SPIN_CAP (1u << 22)

__device__ __forceinline__ unsigned xb_ld(unsigned* p)              { return __hip_atomic_load(p, __ATOMIC_RELAXED, __HIP_MEMORY_SCOPE_AGENT); }
__device__ __forceinline__ unsigned xb_add(unsigned* p, unsigned v) { return __hip_atomic_fetch_add(p, v, __ATOMIC_RELAXED, __HIP_MEMORY_SCOPE_AGENT); }
__device__ __forceinline__ unsigned xb_xcc_id() { return (unsigned)__builtin_amdgcn_s_getreg((3 << 11) | 20) & 0xFu; }
#define XB_SPIN(cond, bar) do { unsigned _sp = 0; while (cond) { __builtin_amdgcn_s_sleep(1); \
    if ((++_sp & 255u) == 0u) { if (xb_ld(&(bar)[XB_TMO])) break; if (_sp > XB_SPIN_CAP) { atomicAdd(&(bar)[XB_TMO], 1u); break; } } } } while (0)

struct XcdBarrier {
    unsigned* bar; unsigned x;
    volatile LAS unsigned* st;
};

__device__ __forceinline__ XcdBarrier xcd_barrier_post(unsigned* bar, volatile LAS unsigned* st) {
    XcdBarrier b; b.bar = bar; b.x = xb_xcc_id(); b.st = st;
    if (threadIdx.x == 0) (void)xb_add(&bar[XB_XCNT(b.x)], 1u);
    return b;
}
__device__ __forceinline__ void xcd_barrier_complete(unsigned* bar, unsigned x, unsigned& nloc, unsigned& nx) {
    const unsigned G = gridDim.x * gridDim.y * gridDim.z;
    unsigned sum, cnt, mine, sp = 0u;
    for (;;) {
        sum = 0u; cnt = 0u; mine = 0u;
#pragma unroll
        for (unsigned j = 0; j < 16; ++j) { const unsigned c = xb_ld(&bar[XB_XCNT(j)]); sum += c; cnt += (c > 0u) ? 1u : 0u; mine = (j == x) ? c : mine; }
        if (sum == G) break;
        __builtin_amdgcn_s_sleep(1);
        if ((++sp & 255u) == 0u) { if (xb_ld(&bar[XB_TMO])) break; if (sp > XB_SPIN_CAP) { atomicAdd(&bar[XB_TMO], 1u); break; } }
    }
    nloc = mine > 0u ? mine : 1u; nx = cnt > 0u ? cnt : 1u;
}

__device__ __forceinline__ void xcd_barrier(const XcdBarrier& b) {
    asm volatile("s_waitcnt vmcnt(0)" ::: "memory");
    __syncthreads();
    if (threadIdx.x == 0) {
        unsigned* bar = b.bar;
        __builtin_amdgcn_s_waitcnt(0);
        unsigned nloc = b.st[0], nx = b.st[1];
        if (nloc == 0u) { xcd_barrier_complete(bar, b.x, nloc, nx); b.st[0] = nloc; b.st[1] = nx; }
        const unsigned old = xb_add(&bar[XB_XSUB(b.x)], 1u);
        const unsigned gen = old / nloc;
        if (old + 1u == (gen + 1u) * nloc) {
            __builtin_amdgcn_fence(__ATOMIC_RELEASE, "agent");
            asm volatile("s_waitcnt vmcnt(0)" ::: "memory");
            const unsigned og = xb_add(&bar[XB_TOP], 1u);
            const unsigned tg = og / nx;
            if (og + 1u == (tg + 1u) * nx) xb_add(&bar[XB_TOPGEN], 1u);
            else XB_SPIN(xb_ld(&bar[XB_TOPGEN]) == tg, bar);
            __builtin_amdgcn_fence(__ATOMIC_ACQUIRE, "agent");
            xb_add(&bar[XB_XGEN(b.x)], 1u);
            asm volatile("s_waitcnt vmcnt(0)" ::: "memory");
        } else {
            XB_SPIN(xb_ld(&bar[XB_XGEN(b.x)]) == gen, bar);
            __builtin_amdgcn_fence(__ATOMIC_ACQUIRE, "agent");
            asm volatile("s_waitcnt vmcnt(0)" ::: "memory");
        }
    }
    __syncthreads();
}

constexpr int NWAVES = 8;
constexpr int BATCH = 8, T = 2048, D = 1024, M = BATCH * T;
constexpr int IN_COLS = 9224;
constexpr int NPROJ = 7168;
constexpr int C_DNQ = 0, C_DNK = 512, C_DNV = 1024, C_DNZ = 1536, C_SQ = 2048, C_SK = 3584, C_SV = 5120, C_SZ = 6656;
constexpr float EPS = 1e-6f;
constexpr float QK_SCALE = 0.08838834764831845f;

constexpr size_t MiB = 1u << 20;
constexpr size_t WS_CTL = 0, CTL_ZERO_BYTES = 32768;
constexpr size_t WS_BG = 1 * MiB;
constexpr size_t WS_ROPE = 1 * MiB + 512 * 1024;
constexpr size_t WS_WG = 2 * MiB;
constexpr size_t WS_WDN = 6 * MiB, WS_WSWA = 7 * MiB;
constexpr size_t WS_WOUT = 8 * MiB;
constexpr size_t WS_WIN = 10 * MiB;
constexpr size_t WS_PROJ = 32 * MiB;
constexpr size_t WS_END = 256 * MiB;
static_assert(WS_WIN + (size_t)NPROJ * D * 2 <= WS_PROJ && WS_PROJ + (size_t)M * NPROJ * 2 <= WS_END, "d_ws map");
constexpr size_t OUT_LT = 32 * MiB, OUT_A = 48 * MiB, OUT_HALO = 58 * MiB, OUT_CS = 61 * MiB;
constexpr size_t WS_LSE = 24 * MiB;
constexpr size_t OUT_ODN = 32 * MiB, OUT_OSWA = 48 * MiB;
constexpr size_t PJ_SCR1 = 0, PJ_SCR2 = 32 * MiB, PJ_SCR3 = 64 * MiB, PJ_MERGED = 96 * MiB;
constexpr int CW_BAR = 4096;

constexpr int RING_OFF = 0, RING_BYTES = 147456;
constexpr int LDSCTL_OFF = RING_BYTES, MISC_OFF = LDSCTL_OFF + 320;
constexpr int LDS_BYTES = 163840;


struct Frame {
    LAS unsigned char* lds;
    volatile LAS unsigned* MISC;
    gu32* ctl;
    int tid, lane, wave;
    int vcu, G;
    const float *x, *norm_w, *w_in, *conv_w, *a_log, *dt_bias, *dn_norm_w, *q_norm_w, *k_norm_w, *w_bdn, *w_bswa, *w_out;
    float* out;
    bf16 *WinT, *WgT, *WdnT, *WswaT, *WoutT, *H, *PROJ;
    float* BG; float* ROPE; float* LSE; float* LT; float* CS; bf16* AIMG; bf16* HALO; bf16* ODN; bf16* OSWA;
};
template <int N> __device__ __forceinline__ float row_ror(float v) { return __builtin_bit_cast(float, __builtin_amdgcn_update_dpp(0, __builtin_bit_cast(int, v), 0x120 + N, 0xf, 0xf, true)); }
__device__ __forceinline__ float row16_sum(float v) { v += row_ror<8>(v); v += row_ror<4>(v); v += row_ror<2>(v); v += row_ror<1>(v); return v; }
__device__ __forceinline__ float wave_sum(float v) {
    v = row16_sum(v);
    { const auto t = __builtin_amdgcn_permlane16_swap(__float_as_uint(v), __float_as_uint(v), false, false); v = __uint_as_float(t[0]) + __uint_as_float(t[1]); }
    { const auto t = __builtin_amdgcn_permlane32_swap(__float_as_uint(v), __float_as_uint(v), false, false); v = __uint_as_float(t[0]) + __uint_as_float(t[1]); }
    return v;
}
__device__ __forceinline__ float bf_lo(unsigned w) { return __builtin_bit_cast(float, w << 16); }
__device__ __forceinline__ float bf_hi(unsigned w) { return __builtin_bit_cast(float, w & 0xffff0000u); }
__device__ __forceinline__ float bf2f(bf16 v) { return __builtin_bit_cast(float, (unsigned)v << 16); }
__device__ __forceinline__ float siluf_(float a) { return a * __builtin_amdgcn_rcpf(1.0f + __expf(-a)); }
__device__ __forceinline__ float sigm_(float a) { return __builtin_amdgcn_rcpf(1.0f + __expf(-a)); }

struct TrItem { const float* src; bf16* dst; int ldw, K, k0; };
__device__ __forceinline__ void tr_load(const TrItem& t, float (&tv)[32], int lane) {
#pragma unroll
    for (int i = 0; i < 32; ++i) { const int kk = 2 * i + (lane >> 5); tv[i] = t.src[(size_t)(t.k0 + kk) * t.ldw + (lane & 31)]; }
}
__device__ __forceinline__ void tr_scatter(const float (&tv)[32], LAS float* scr, int lane) {
#pragma unroll
    for (int i = 0; i < 32; ++i) { const int kk = 2 * i + (lane >> 5); scr[kk * 33 + (lane & 31)] = tv[i]; }
    LDS_WAIT(); asm volatile("" ::: "memory");
}
__device__ __forceinline__ void tr_store(const TrItem& t, LAS float* scr, int lane) {
    const int c = lane & 7;
#pragma unroll
    for (int j = 0; j < 4; ++j) { const int n = (lane >> 3) + 8 * j; const LAS float* s = scr + (8 * c) * 33 + n;
        v4u o; o.x = pk2(s[0 * 33], s[1 * 33]); o.y = pk2(s[2 * 33], s[3 * 33]); o.z = pk2(s[4 * 33], s[5 * 33]); o.w = pk2(s[6 * 33], s[7 * 33]);
        *(GAS v4u*)(t.dst + (size_t)n * t.K + t.k0 + 8 * c) = o; }
    LDS_WAIT(); asm volatile("" ::: "memory");
}
constexpr int TR_I_IN = 16 * (NPROJ / 32), TR_I_G = 16 * 64, TR_I_DN = 8 * 32, TR_I_SWA = 8 * 32, TR_I_OUT = 16 * 32, TR_NITEMS = TR_I_IN + TR_I_G + TR_I_DN + TR_I_SWA + TR_I_OUT;
__device__ __forceinline__ TrItem tr_decode(Frame& F, int it) {
    TrItem t; int r = it;
    if (r < TR_I_IN) { const int kb = r / (NPROJ / 32), nb = r % (NPROJ / 32), n0 = nb * 32, sc = n0 < 2048 ? n0 : n0 + 8; t.src = F.w_in + sc; t.ldw = IN_COLS; t.dst = F.WinT + (size_t)n0 * D; t.K = D; t.k0 = kb * 64; return t; } r -= TR_I_IN;
    if (r < TR_I_G) { const int kb = r / 64, nb = r % 64, n0 = nb * 32; t.src = F.w_in + 7176 + n0; t.ldw = IN_COLS; t.dst = F.WgT + (size_t)n0 * D; t.K = D; t.k0 = kb * 64; return t; } r -= TR_I_G;
    if (r < TR_I_DN) { const int kb = r / 32, nb = r % 32, n0 = nb * 32; t.src = F.w_bdn + n0; t.ldw = D; t.dst = F.WdnT + (size_t)n0 * 512; t.K = 512; t.k0 = kb * 64; return t; } r -= TR_I_DN;
    if (r < TR_I_SWA) { const int kb = r / 32, nb = r % 32, n0 = nb * 32; t.src = F.w_bswa + n0; t.ldw = D; t.dst = F.WswaT + (size_t)n0 * 512; t.K = 512; t.k0 = kb * 64; return t; } r -= TR_I_SWA;
    { const int kb = r / 32, nb = r % 32, n0 = nb * 32; t.src = F.w_out + n0; t.ldw = D; t.dst = F.WoutT + (size_t)n0 * D; t.K = D; t.k0 = kb * 64; return t; }
}
__device__ __forceinline__ void tr_run(Frame& F, int lo, int hi, LAS float* scr, int gw, int NGW) {
    const int lane = F.lane;
    if (lo + gw < hi) {
        float tv[32]; TrItem cur = tr_decode(F, lo + gw); tr_load(cur, tv, lane);
        for (int it = lo + gw; it < hi; it += NGW) {
            tr_scatter(tv, scr, lane);
            TrItem nxt = cur; const bool more = it + NGW < hi;
            if (more) { nxt = tr_decode(F, it + NGW); tr_load(nxt, tv, lane); }
            tr_store(cur, scr, lane);
            cur = nxt;
        }
    }
}
__device__ __forceinline__ void p0_prologue(Frame& F) {
    LAS float* scr = (LAS float*)(F.lds + RING_OFF + F.wave * 8704);
    const int gw = F.vcu * NWAVES + F.wave, NGW = F.G * NWAVES, lane = F.lane;
    LAS float* wsm = (LAS float*)(F.lds + RING_OFF + 8 * 8704);
    for (int idx = F.tid; idx < 1024 * 8; idx += NWAVES * 64) { const int k = idx >> 3, j = idx & 7; const float v = F.w_in[(size_t)k * IN_COLS + 2048 + j];
        const int ln = (k & 255) >> 2, e = k & 3, jj = k >> 8, c = jj * 4 + e, half = j >> 2; wsm[((half * 16 + c) * 64 + ln) * 4 + (j & 3)] = v; }
    __syncthreads();
    tr_run(F, 0, TR_I_IN, scr, gw, NGW);
    {
        static constexpr double INVF[16] = {1.0, 0.44036660267178046, 0.19392274474868576, 0.08539710028576561, 0.03760603093086393, 0.016560440080994446, 0.007292664737217109, 0.003211445994752591,
                                            0.001414213562373095, 0.000622772421914596, 0.0002742481756762073, 0.00012076973741146504, 5.318295896944988e-05, 2.341999896140934e-05, 1.031338537721246e-05, 4.5416704806078695e-06};
        for (int gt = F.vcu * (NWAVES * 64) + F.tid; gt < T * 16; gt += F.G * NWAVES * 64) {
            const int pos = gt >> 4, i = gt & 15;
            double a = (double)pos * INVF[i] * 0.15915494309189535;
            a -= __builtin_rint(a);
            const float af = (float)a;
            F.ROPE[gt * 2] = __builtin_amdgcn_cosf(af); F.ROPE[gt * 2 + 1] = __builtin_amdgcn_sinf(af);
        }
    }
    f32x4 xn[4];
    { const GAS f32x4* xr = (const GAS f32x4*)(F.x + (size_t)gw * D) + lane;
#pragma unroll
      for (int j = 0; j < 4; ++j) xn[j] = xr[64 * j]; }
    for (int m = gw; m < M; m += NGW) {
        f32x4 v[4]; float ss = 0.f;
#pragma unroll
        for (int j = 0; j < 4; ++j) { v[j] = xn[j]; ss += (v[j].x * v[j].x + v[j].y * v[j].y) + (v[j].z * v[j].z + v[j].w * v[j].w); }
        if (m + NGW < M) { const GAS f32x4* xr = (const GAS f32x4*)(F.x + (size_t)(m + NGW) * D) + lane;
#pragma unroll
            for (int j = 0; j < 4; ++j) xn[j] = xr[64 * j]; }
        const float rstd = __builtin_amdgcn_rsqf(wave_sum(ss) * (1.f / D) + EPS);
#pragma unroll
        for (int j = 0; j < 4; ++j) { const f32x4 nw = ((const GAS f32x4*)F.norm_w)[lane + 64 * j]; v[j] = (v[j] * rstd) * nw; }
        GAS unsigned long long* o8 = (GAS unsigned long long*)(F.H + (size_t)m * D) + lane;
#pragma unroll
        for (int j = 0; j < 4; ++j) o8[64 * j] = (unsigned long long)pk2(v[j].x, v[j].y) | ((unsigned long long)pk2(v[j].z, v[j].w) << 32);
        f32x4 plo = {0.f, 0.f, 0.f, 0.f}, phi = {0.f, 0.f, 0.f, 0.f};
#pragma unroll
        for (int jj = 0; jj < 4; ++jj)
#pragma unroll
            for (int e = 0; e < 4; ++e) { const int c = jj * 4 + e; const float hv = v[jj][e];
                const f32x4 wlo = *(const LAS f32x4*)(wsm + ((0 * 16 + c) * 64 + lane) * 4), whi = *(const LAS f32x4*)(wsm + ((1 * 16 + c) * 64 + lane) * 4);
                plo += wlo * hv; phi += whi * hv; }
        const float p0 = wave_sum(plo.x), p1 = wave_sum(plo.y), p2 = wave_sum(plo.z), p3 = wave_sum(plo.w), p4 = wave_sum(phi.x), p5 = wave_sum(phi.y), p6 = wave_sum(phi.z), p7 = wave_sum(phi.w);
        float val = p0; val = lane == 1 ? p1 : val; val = lane == 2 ? p2 : val; val = lane == 3 ? p3 : val; val = lane == 4 ? p4 : val; val = lane == 5 ? p5 : val; val = lane == 6 ? p6 : val; val = lane == 7 ? p7 : val;
        if (lane < 8) { const int h = lane & 3; float o;
            if (lane < 4) o = sigm_(val);
            else { const float xx = val + F.dt_bias[h]; const float sp = xx > 20.f ? xx : log1pf(expf(xx)); o = -expf(F.a_log[h]) * sp; }
            F.BG[(size_t)m * 8 + lane] = o; }
    }
}

constexpr float SC2 = QK_SCALE * 1.4426950408889634f;
typedef short v4i16_t __attribute__((ext_vector_type(4)));
__device__ __forceinline__ int offK(int row, int b) { return row * 256 + (b ^ ((row & 15) << 4)); }
__device__ __forceinline__ int offV(int row, int b) { return row * 256 + (b ^ ((row & 7) << 5)); }
__device__ __forceinline__ v4i16_t vtr(const LAS unsigned char* p) { return __builtin_amdgcn_ds_read_tr16_b64_v4i16((LAS v4i16_t*)p); }
struct AttnItem { int b, g, h, r, n, sh; };
__device__ __forceinline__ float xrow_max(float v) {
    { const auto t = __builtin_amdgcn_permlane16_swap(__float_as_uint(v), __float_as_uint(v), false, false); v = fmaxf(__uint_as_float(t[0]), __uint_as_float(t[1])); }
    { const auto t = __builtin_amdgcn_permlane32_swap(__float_as_uint(v), __float_as_uint(v), false, false); v = fmaxf(__uint_as_float(t[0]), __uint_as_float(t[1])); }
    return v; }
__device__ __forceinline__ float xrow_sum(float v) {
    { const auto t = __builtin_amdgcn_permlane16_swap(__float_as_uint(v), __float_as_uint(v), false, false); v = __uint_as_float(t[0]) + __uint_as_float(t[1]); }
    { const auto t = __builtin_amdgcn_permlane32_swap(__float_as_uint(v), __float_as_uint(v), false, false); v = __uint_as_float(t[0]) + __uint_as_float(t[1]); }
    return v; }
__device__ __forceinline__ void attn_stage_half(Frame& F, const AttnItem& a, int hlog, int slot, LAS unsigned char* ldsK, LAS unsigned char* ldsV) {
    const int lane = F.lane, w = F.wave; const size_t rowb = (size_t)a.b * T;
#pragma unroll
    for (int i = 0; i < 4; ++i) { const int p = 4 * w + i, jl = 4 * p + (lane >> 4), s = 128 * (a.n - 1 + hlog) + jl; const int pos = (s << a.sh) + a.r;
        const bf16* rp = F.PROJ + (rowb + pos) * NPROJ + a.g * 512 + a.h * 128; const int pc = lane & 15;
        __builtin_amdgcn_global_load_lds((const unsigned*)(rp + C_SK + ((pc ^ (jl & 15)) * 8)), (LAS unsigned*)(ldsK + slot * 32768 + p * 1024), 16, 0, 0);
        __builtin_amdgcn_global_load_lds((const unsigned*)(rp + C_SV + ((pc ^ ((jl & 7) << 1)) * 8)), (LAS unsigned*)(ldsV + slot * 32768 + p * 1024), 16, 0, 0); }
}
__device__ __forceinline__ void p2_attn_run(Frame& F, int q) {
    const int lane = F.lane, w = F.wave, l15 = lane & 15, g4 = lane >> 4;
    LAS unsigned char* ldsK = F.lds + RING_OFF; LAS unsigned char* ldsV = F.lds + RING_OFF + 65536;
    const int bgh = q >> 1, hf = q & 1;
    AttnItem a; a.g = bgh % 3; { const int bh = bgh / 3; a.h = bh & 3; a.b = bh >> 2; } a.sh = 2 * a.g;
    int par = 0; bool staged = false;
    v4u qn[4];
    { AttnItem a0 = a; const int x0 = hf * 8; a0.r = x0 >> (4 - a.sh); a0.n = x0 & ((16 >> a.sh) - 1);
      const int posq0 = ((128 * a0.n + 16 * w + l15) << a.sh) + a0.r; const bf16* q0 = F.PROJ + ((size_t)a.b * T + posq0) * NPROJ + C_SQ + a.g * 512 + a.h * 128;
#pragma unroll
      for (int kk = 0; kk < 4; ++kk) qn[kk] = *(const GAS v4u*)(q0 + 32 * kk + 8 * g4); }
    for (int k = 0; k < 8; ++k) {
    const int x = hf * 8 + k; a.r = x >> (4 - a.sh); a.n = x & ((16 >> a.sh) - 1);
    const int g = a.g, h = a.h, r = a.r, n = a.n, sh = a.sh;
    const size_t rowb = (size_t)a.b * T;
    if (!staged) { par = 0; if (n > 0) attn_stage_half(F, a, 0, 0, ldsK, ldsV); attn_stage_half(F, a, 1, 1, ldsK, ldsV); }
    AttnItem an = a; bool nxt_one = false;
    if (k < 7) { const int xn = x + 1; an.r = xn >> (4 - a.sh); an.n = xn & ((16 >> a.sh) - 1); nxt_one = (an.n == 0) || (an.r == a.r && an.n == a.n + 1); }
    const int qi = 16 * w + l15, sq = 128 * n + qi, posq = (sq << sh) + r;
    bf16* qrow = F.PROJ + (rowb + posq) * NPROJ + C_SQ + g * 512 + h * 128;
    asm volatile("s_waitcnt vmcnt(0)" ::: "memory");
    __syncthreads();
    pg8::bf16x8 qf[4];
#pragma unroll
    for (int kk = 0; kk < 4; ++kk) qf[kk] = __builtin_bit_cast(pg8::bf16x8, qn[kk]);
    if (k < 7) { const int posqn = ((128 * an.n + qi) << sh) + an.r; const bf16* qr2 = F.PROJ + (rowb + posqn) * NPROJ + C_SQ + g * 512 + h * 128;
#pragma unroll
        for (int kk = 0; kk < 4; ++kk) qn[kk] = *(const GAS v4u*)(qr2 + 32 * kk + 8 * g4); }
    float m = -1e30f, lsum = 0.f;
    f32x4 O[8];
#pragma unroll
    for (int dt = 0; dt < 8; ++dt) O[dt] = (f32x4){0.f, 0.f, 0.f, 0.f};
    const int jb0 = 32 * (w >> 1);
    const int trq = l15 >> 2, trp = l15 & 3;
#pragma unroll
    for (int c = 0; c < 5; ++c) {
        const int jb = jb0 + 32 * c;
        if (c == 4) {
            asm volatile("s_waitcnt lgkmcnt(0)" ::: "memory"); __builtin_amdgcn_s_barrier(); asm volatile("" ::: "memory");
            if (nxt_one) attn_stage_half(F, an, 1, par, ldsK, ldsV);
        }
        if (n == 0 && jb + 31 < 128) continue;
        const int jp = (((jb >> 7) ^ par) << 7) + (jb & 127);
        f32x4 s0 = {0.f, 0.f, 0.f, 0.f}, s1 = {0.f, 0.f, 0.f, 0.f};
        {   pg8::bf16x8 ka[4], kb[4];
#pragma unroll
            for (int kk = 0; kk < 4; ++kk) { ka[kk] = *(const LAS pg8::bf16x8*)(ldsK + offK(jp + l15, 64 * kk + 16 * g4)); kb[kk] = *(const LAS pg8::bf16x8*)(ldsK + offK(jp + 16 + l15, 64 * kk + 16 * g4)); }
            __builtin_amdgcn_sched_barrier(0);
#pragma unroll
            for (int kk = 0; kk < 4; ++kk) { s0 = __builtin_amdgcn_mfma_f32_16x16x32_bf16(ka[kk], qf[kk], s0, 0, 0, 0); s1 = __builtin_amdgcn_mfma_f32_16x16x32_bf16(kb[kk], qf[kk], s1, 0, 0, 0); } }
        float xs[8]; float tmax = -INFINITY;
        if (c == 0 || c == 4) {
#pragma unroll
            for (int e = 0; e < 4; ++e) {
                const int j0 = jb + 4 * g4 + e, j1 = j0 + 16; const int d0 = j0 - qi, d1 = j1 - qi;
                const bool ok0 = d0 >= 0 && d0 <= 128 && (n > 0 || j0 >= 128), ok1 = d1 >= 0 && d1 <= 128 && (n > 0 || j1 >= 128);
                xs[e] = ok0 ? s0[e] * SC2 : -INFINITY; xs[4 + e] = ok1 ? s1[e] * SC2 : -INFINITY;
                tmax = fmaxf(tmax, fmaxf(xs[e], xs[4 + e])); }
        } else {
#pragma unroll
            for (int e = 0; e < 4; ++e) { xs[e] = s0[e] * SC2; xs[4 + e] = s1[e] * SC2; tmax = fmaxf(tmax, fmaxf(xs[e], xs[4 + e])); }
        }
        tmax = xrow_max(tmax);
        const float mn = fmaxf(m, tmax), alpha = __builtin_amdgcn_exp2f(m - mn);
        float ps = 0.f;
#pragma unroll
        for (int e = 0; e < 8; ++e) { xs[e] = __builtin_amdgcn_exp2f(xs[e] - mn); ps += xs[e]; }
        lsum = lsum * alpha + ps;
        if (__builtin_amdgcn_ballot_w64(mn > m) != 0ull) {
#pragma unroll
            for (int dt = 0; dt < 8; ++dt) O[dt] = O[dt] * alpha; }
        m = mn;
        v4u pw; pw.x = pk2(xs[0], xs[1]); pw.y = pk2(xs[2], xs[3]); pw.z = pk2(xs[4], xs[5]); pw.w = pk2(xs[6], xs[7]);
        const pg8::bf16x8 pf = __builtin_bit_cast(pg8::bf16x8, pw);
        const int vr1 = jp + 4 * g4 + trq, vr2 = vr1 + 16;
        v4i16_t tv1[8], tv2[8];
#pragma unroll
        for (int dt = 0; dt < 8; ++dt) { tv1[dt] = vtr(ldsV + offV(vr1, 32 * dt + 8 * trp)); tv2[dt] = vtr(ldsV + offV(vr2, 32 * dt + 8 * trp)); }
#pragma unroll
        for (int dt = 0; dt < 8; ++dt) {
            const pg8::bf16x8 af = {tv1[dt][0], tv1[dt][1], tv1[dt][2], tv1[dt][3], tv2[dt][0], tv2[dt][1], tv2[dt][2], tv2[dt][3]};
            O[dt] = __builtin_amdgcn_mfma_f32_16x16x32_bf16(af, pf, O[dt], 0, 0, 0);
        }
    }
    const float lt = xrow_sum(lsum);
    const float inv = __builtin_amdgcn_rcpf(lt);
#pragma unroll
    for (int dt = 0; dt < 8; ++dt) { const f32x4 o = O[dt] * inv;
        const unsigned long long pk = (unsigned long long)pk2(o[0], o[1]) | ((unsigned long long)pk2(o[2], o[3]) << 32);
        *(GAS unsigned long long*)(qrow + 16 * dt + 4 * g4) = pk; }
    if (g4 == 0) F.LSE[((rowb + posq) * 3 + g) * 4 + h] = m + __builtin_amdgcn_logf(lt);
    if (nxt_one) { staged = true; par ^= 1; }
    else { staged = false; asm volatile("s_waitcnt lgkmcnt(0)" ::: "memory"); __builtin_amdgcn_s_barrier(); asm volatile("" ::: "memory"); }
    }
}
#define PREP_MAP() const int gi_ = (tid - 256) >> 4, unit_ = F.wave < 4 ? tid : (16 + (gi_ >> 1)) * 16 + (tid & 15), nr = F.wave < 4 ? 8 : 4; \
    const int rg = unit_ / 48, rem = unit_ - rg * 48, which = rem >> 4, ch = rem & 15, col = which * 512 + h * 128 + ch * 8, rbase = rg * 8 + (F.wave < 4 ? 0 : 4 * (gi_ & 1))
__device__ __forceinline__ void prepA_load(Frame& F, int item, v4u (&raw)[11], f32x4 (&cw)[4][2], float& gv, float& bt) {
    const int tid = F.tid; const int h = item & 3, cg = item >> 2, n = cg & 31; const size_t row0 = (size_t)cg * 64;
    PREP_MAP();
    if (F.wave == 7) { gv = F.BG[(row0 + F.lane) * 8 + 4 + h]; bt = F.BG[(row0 + F.lane) * 8 + h]; }
    {
#pragma unroll
        for (int j = 0; j < 4; ++j) { cw[j][0] = *(const GAS f32x4*)(F.conv_w + j * 1536 + col); cw[j][1] = *(const GAS f32x4*)(F.conv_w + j * 1536 + col + 4); }
#pragma unroll
        for (int i = 0; i < 11; ++i) if (i < nr + 3) { const int rr = rbase - 3 + i;
            if (rr >= 0) raw[i] = *(const GAS v4u*)(F.PROJ + (row0 + rr) * NPROJ + col);
            else if (n > 0) raw[i] = *(const GAS v4u*)(F.HALO + ((size_t)(cg - 1) * 3 + (rr + 3)) * 1536 + col);
            else raw[i] = (v4u){0u, 0u, 0u, 0u}; }
    }
}
__device__ __forceinline__ void prepA_conv(Frame& F, int item, const v4u (&raw)[11], const f32x4 (&cw)[4][2], float gv, float bt, int buf) {
    const int tid = F.tid, lane = F.lane, w = F.wave; const int h = item & 3, cg = item >> 2; const size_t row0 = (size_t)cg * 64;
    LAS unsigned char* Qi = F.lds + RING_OFF + buf * 33792; LAS unsigned char* Ki = Qi + 16384; LAS float* gcs = (LAS float*)(Ki + 16384); LAS float* bts = gcs + 64;
    PREP_MAP();
    if (w == 7) {
        float x = gv;
#define DPP_ADD(ctrl, rmask) x += __builtin_bit_cast(float, __builtin_amdgcn_update_dpp(0, __builtin_bit_cast(int, x), ctrl, rmask, 0xf, false))
        DPP_ADD(0x111, 0xf); DPP_ADD(0x112, 0xf); DPP_ADD(0x114, 0xf); DPP_ADD(0x118, 0xf); DPP_ADD(0x142, 0xa); DPP_ADD(0x143, 0xc);
#undef DPP_ADD
        const float glast = __builtin_bit_cast(float, __builtin_amdgcn_readlane(__builtin_bit_cast(int, x), 63));
        gcs[lane] = x; bts[lane] = bt;
        float* cs = F.CS + (size_t)item * 256; cs[lane] = __expf(x); cs[64 + lane] = bt; cs[128 + lane] = __expf(glast - x); if (lane == 0) cs[192] = __expf(glast);
    }
    {
#pragma unroll
        for (int r = 0; r < 8; ++r) if (r < nr) {
            float y[8];
#pragma unroll
            for (int e = 0; e < 8; ++e) y[e] = 0.f;
#pragma unroll
            for (int j = 0; j < 4; ++j) { const v4u rv = raw[r + j];
                const float xv[8] = {bf_lo(rv.x), bf_hi(rv.x), bf_lo(rv.y), bf_hi(rv.y), bf_lo(rv.z), bf_hi(rv.z), bf_lo(rv.w), bf_hi(rv.w)};
#pragma unroll
                for (int e = 0; e < 8; ++e) y[e] += cw[j][e >> 2][e & 3] * xv[e]; }
            float ss = 0.f;
#pragma unroll
            for (int e = 0; e < 8; ++e) { y[e] = siluf_(y[e]); ss += y[e] * y[e]; }
            ss = row16_sum(ss);
            const float scl = which == 2 ? 1.f : __builtin_amdgcn_rsqf(ss + EPS) * (which == 0 ? QK_SCALE : 1.f);
            v4u o; o.x = pk2(y[0] * scl, y[1] * scl); o.y = pk2(y[2] * scl, y[3] * scl); o.z = pk2(y[4] * scl, y[5] * scl); o.w = pk2(y[6] * scl, y[7] * scl);
            const int rr = rbase + r;
            *(GAS v4u*)(F.PROJ + (row0 + rr) * NPROJ + col) = o;
            if (which < 2) *(LAS v4u*)((which == 0 ? Qi : Ki) + offK(rr, ch * 16)) = o;
        }
    }
}
__device__ __forceinline__ void prepA_mfma(Frame& F, int item, int buf) {
    const int lane = F.lane, w = F.wave, l15 = lane & 15, g4 = lane >> 4;
    LAS unsigned char* Qi = F.lds + RING_OFF + buf * 33792; LAS unsigned char* Ki = Qi + 16384; LAS float* gcs = (LAS float*)(Ki + 16384); LAS float* bts = gcs + 64;
    const int whichm = w >> 2, wi = w & 3; const LAS unsigned char* Xi = whichm ? Qi : Ki;
    float* Lg = F.LT + (size_t)item * 4096; bf16* Ag = F.AIMG + (size_t)item * 4096;
#define BLK(mt, nt, v) ((mt) | ((nt) << 2) | ((v) << 4))
    const unsigned listL = wi == 0 ? (BLK(3, 3, 1) | BLK(0, 0, 1) << 8 | BLK(1, 0, 1) << 16) : wi == 1 ? (BLK(3, 2, 1) | BLK(1, 1, 1) << 8 | BLK(2, 0, 1) << 16) : wi == 2 ? (BLK(3, 1, 1) | BLK(2, 2, 1) << 8) : (BLK(3, 0, 1) | BLK(2, 1, 1) << 8);
    const unsigned listA = wi == 0 ? (BLK(3, 3, 1) | BLK(0, 0, 1) << 8 | BLK(1, 0, 1) << 16) : wi == 1 ? (BLK(3, 2, 1) | BLK(1, 1, 1) << 8 | BLK(2, 0, 1) << 16) : wi == 2 ? (BLK(3, 1, 1) | BLK(2, 2, 1) << 8 | BLK(0, 1, 1) << 16) : (BLK(3, 0, 1) | BLK(2, 1, 1) << 8 | BLK(2, 3, 1) << 16);
#undef BLK
    const unsigned list = whichm ? listA : listL;
#pragma unroll
    for (int s = 0; s < 3; ++s) {
        const unsigned v = (list >> (8 * s)) & 0xffu; const int mt = v & 3, nt = (v >> 2) & 3;
        if (!(v & 16u)) continue;
        f32x4 acc = {0.f, 0.f, 0.f, 0.f};
        const int cp = 16 * nt + l15; const float gcp = gcs[cp];
        float gcr[4];
#pragma unroll
        for (int e = 0; e < 4; ++e) gcr[e] = gcs[16 * mt + 4 * g4 + e];
        if (nt <= mt) {
            pg8::bf16x8 a[4], bb[4];
#pragma unroll
            for (int kk = 0; kk < 4; ++kk) { a[kk] = *(const LAS pg8::bf16x8*)(Xi + offK(16 * mt + l15, 64 * kk + 16 * g4)); bb[kk] = *(const LAS pg8::bf16x8*)(Ki + offK(16 * nt + l15, 64 * kk + 16 * g4)); }
            __builtin_amdgcn_sched_barrier(0);
#pragma unroll
            for (int kk = 0; kk < 4; ++kk) acc = __builtin_amdgcn_mfma_f32_16x16x32_bf16(a[kk], bb[kk], acc, 0, 0, 0); }
#pragma unroll
        for (int e = 0; e < 4; ++e) { const int c = 16 * mt + 4 * g4 + e; const float dec = __expf(gcr[e] - gcp);
            if (whichm == 0) { const float val = (c > cp) ? bts[c] * acc[e] * dec : 0.f; Lg[c * 64 + cp] = val; }
            else { const float val = (c >= cp) ? acc[e] * dec : 0.f; Ag[c * 64 + 32 * (nt >> 1) + 8 * (l15 >> 2) + 4 * (nt & 1) + (l15 & 3)] = (bf16)f2bf(val); } }
    }
}
typedef unsigned v2u __attribute__((ext_vector_type(2)));
__device__ __forceinline__ pg8::bf16x8 packB(const f32x4 a, const f32x4 b) { const v4u r = {pk2(a[0], a[1]), pk2(a[2], a[3]), pk2(b[0], b[1]), pk2(b[2], b[3])}; return __builtin_bit_cast(pg8::bf16x8, r); }
__device__ __forceinline__ pg8::bf16x8 frag2(const LAS unsigned char* p1, const LAS unsigned char* p2) {
    const v2u a = *(const LAS v2u*)p1, b = *(const LAS v2u*)p2; const v4u r = {a.x, a.y, b.x, b.y}; return __builtin_bit_cast(pg8::bf16x8, r); }
__device__ __forceinline__ void dn_prep_B4(Frame& F, int base) {
    const int lane = F.lane, w = F.wave, it4 = w >> 1, p = w & 1, l15 = lane & 15, g4 = lane >> 4;
    const int item = base + it4;
    LAS float* Ls = (LAS float*)(F.lds + RING_OFF + it4 * 24576);
    LAS unsigned char* Tl = F.lds + RING_OFF + it4 * 24576 + 16384;
    { const float* Lg = F.LT + (size_t)item * 4096 + p * 2048;
#pragma unroll
      for (int i = 0; i < 8; ++i) { const f32x4 v = ((const GAS f32x4*)Lg)[i * 64 + lane]; *(LAS f32x4*)(Ls + p * 2048 + (i * 64 + lane) * 4) = v; } }
    asm volatile("s_waitcnt vmcnt(0) lgkmcnt(0)" ::: "memory");
    const int rb0 = 32 * p, rb = rb0 + 16 * (g4 & 1), q4 = l15 >> 2, pq = l15 & 3;
    {
        float Td[16];
#pragma unroll
        for (int i = 0; i < 16; ++i) {
            float a0 = 0.f, a1 = 0.f;
            const LAS float* Lr = Ls + (rb + i) * 64 + rb;
#pragma unroll
            for (int q = 0; q < 4; ++q) if (4 * q < i) { const f32x4 lv = *(const LAS f32x4*)(Lr + 4 * q);
#pragma unroll
                for (int e = 0; e < 4; ++e) if (4 * q + e < i) { if (e & 1) a1 += lv[e] * Td[4 * q + e]; else a0 += lv[e] * Td[4 * q + e]; } }
            Td[i] = ((l15 == i) ? 1.f : 0.f) - (a0 + a1);
        }
        if (g4 < 2) {
#pragma unroll
            for (int j = 0; j < 16; ++j) *(LAS bf16*)(Tl + (rb + j) * 128 + (rb + l15) * 2) = (bf16)f2bf(Td[j]);
            *(LAS v4u*)(Tl + (rb0 + (lane >> 1)) * 128 + (rb0 + 16) * 2 + (lane & 1) * 16) = (v4u){0u, 0u, 0u, 0u};
        }
        *(LAS v4u*)(Tl + (16 * p + (lane >> 2)) * 128 + 64 + (lane & 3) * 16) = (v4u){0u, 0u, 0u, 0u};
    }
    asm volatile("s_waitcnt lgkmcnt(0)" ::: "memory");
    {
        const int gk = g4 & 1; const pg8::bf16x8 zf = {0, 0, 0, 0, 0, 0, 0, 0};
        const LAS float* lr = Ls + (rb0 + 16 + l15) * 64 + rb0 + 8 * gk; const f32x4 x0 = *(const LAS f32x4*)lr, x1 = *(const LAS f32x4*)(lr + 4);
        const v4i16_t t1 = vtr(Tl + (rb0 + 8 * gk + q4) * 128 + (rb0 + 4 * pq) * 2), t2 = vtr(Tl + (rb0 + 8 * gk + 4 + q4) * 128 + (rb0 + 4 * pq) * 2);
        pg8::bf16x8 af = packB(x0, x1), bfr = {t1[0], t1[1], t1[2], t1[3], t2[0], t2[1], t2[2], t2[3]};
        if (g4 >= 2) { af = zf; bfr = zf; }
        const f32x4 X = __builtin_amdgcn_mfma_f32_16x16x32_bf16(af, bfr, (f32x4){0.f, 0.f, 0.f, 0.f}, 0, 0, 0);
        const v2u alo = *(const LAS v2u*)(Tl + (rb0 + 16 + l15) * 128 + (rb0 + 16) * 2 + 8 * g4);
        const v4u a4 = {alo.x, alo.y, 0u, 0u};
        const f32x4 R = __builtin_amdgcn_mfma_f32_16x16x32_bf16(__builtin_bit_cast(pg8::bf16x8, a4), packB(X, (f32x4){0.f, 0.f, 0.f, 0.f}), (f32x4){0.f, 0.f, 0.f, 0.f}, 0, 0, 0);
#pragma unroll
        for (int e = 0; e < 4; ++e) *(LAS bf16*)(Tl + (rb0 + 16 + 4 * g4 + e) * 128 + (rb0 + l15) * 2) = (bf16)f2bf(-R[e]);
    }
    asm volatile("s_waitcnt lgkmcnt(0)" ::: "memory");
    __syncthreads();
    {
        f32x4 X[2][2];
#pragma unroll
        for (int mt = 0; mt < 2; ++mt) { const LAS float* lr = Ls + (32 + 16 * mt + l15) * 64 + 8 * g4; const f32x4 x0 = *(const LAS f32x4*)lr, x1 = *(const LAS f32x4*)(lr + 4);
            const pg8::bf16x8 af = packB(x0, x1);
#pragma unroll
            for (int nt = 0; nt < 2; ++nt) {
                const v4i16_t t1 = vtr(Tl + (8 * g4 + q4) * 128 + (16 * nt + 4 * pq) * 2), t2 = vtr(Tl + (8 * g4 + 4 + q4) * 128 + (16 * nt + 4 * pq) * 2);
                const pg8::bf16x8 bfr = {t1[0], t1[1], t1[2], t1[3], t2[0], t2[1], t2[2], t2[3]};
                X[mt][nt] = __builtin_amdgcn_mfma_f32_16x16x32_bf16(af, bfr, (f32x4){0.f, 0.f, 0.f, 0.f}, 0, 0, 0); } }
        const LAS unsigned char* tr22 = Tl + (32 + 16 * p + l15) * 128 + 64;
        const pg8::bf16x8 a22 = frag2(tr22 + 8 * g4, tr22 + 32 + 8 * g4);
#pragma unroll
        for (int nt = 0; nt < 2; ++nt) { const f32x4 R = __builtin_amdgcn_mfma_f32_16x16x32_bf16(a22, packB(X[0][nt], X[1][nt]), (f32x4){0.f, 0.f, 0.f, 0.f}, 0, 0, 0);
#pragma unroll
            for (int e = 0; e < 4; ++e) *(LAS bf16*)(Tl + (32 + 16 * p + 4 * g4 + e) * 128 + (16 * nt + l15) * 2) = (bf16)f2bf(-R[e]); }
    }
    asm volatile("s_waitcnt lgkmcnt(0)" ::: "memory");
    __syncthreads();
    { unsigned char* Tg = (unsigned char*)F.LT + (size_t)item * 16384;
#pragma unroll
      for (int i = 0; i < 4; ++i) { const int id = (p * 4 + i) * 64 + lane, row = id >> 3, dc = id & 7;
          const LAS unsigned char* s = Tl + row * 128 + (32 * (dc >> 2) + 4 * (dc & 3)) * 2; const v2u lo = *(const LAS v2u*)s, hi = *(const LAS v2u*)(s + 32);
          *(GAS v4u*)(Tg + id * 16) = (v4u){lo.x, lo.y, hi.x, hi.y}; } }
}


__device__ __forceinline__ void dn_scan2(Frame& F, int unit) {
    const int lane = F.lane, w = F.wave, l15 = lane & 15, g4 = lane >> 4, trq = l15 >> 2, trp = l15 & 3;
    const int half = unit & 1, h = (unit >> 1) & 3, b = unit >> 3;
    LAS unsigned char* L = F.lds + RING_OFF;
    constexpr int BUFS = 58368, O_K = 0, O_Q = 16384, O_T = 32768, O_A = 40960, O_V = 49152, O_CS = 57344, O_O = 2 * BUFS;
    const int lw = w - 4;
#define DN_GLDS(gp, ldsoff) __builtin_amdgcn_global_load_lds((const unsigned*)(gp), (LAS unsigned*)(ldsoff), 16, 0, 0)
#define DN_FSWZ(r) ((((r) & 3) << 2) | (((r) >> 2) & 3))
#define DN_LOAD2(m, Bn) do { const int cgm = b * 32 + (m); const size_t rowm = (size_t)cgm * 64; const int itm = cgm * 4 + h; \
        _Pragma("unroll") for (int i = 0; i < 4; ++i) { const int p = lw * 4 + i, kr = 4 * p + (lane >> 4), kc = (lane & 15) ^ DN_FSWZ(kr & 15); \
            const bf16* pk = F.PROJ + (rowm + kr) * NPROJ + h * 128 + kc * 8; DN_GLDS(pk + C_DNK, (Bn) + O_K + p * 1024); DN_GLDS(pk + C_DNQ, (Bn) + O_Q + p * 1024); } \
        _Pragma("unroll") for (int i = 0; i < 2; ++i) { const int p = lw * 2 + i, tr_ = 8 * p + (lane >> 3), tc = (lane & 7) ^ ((tr_ >> 1) & 7); \
            DN_GLDS((const bf16*)((const unsigned char*)F.LT + (size_t)itm * 16384) + tr_ * 64 + tc * 8, (Bn) + O_T + p * 1024); \
            DN_GLDS(F.AIMG + (size_t)itm * 4096 + tr_ * 64 + tc * 8, (Bn) + O_A + p * 1024); \
            DN_GLDS(F.PROJ + (rowm + tr_) * NPROJ + C_DNV + h * 128 + 64 * half + (lane & 7) * 8, (Bn) + O_V + p * 1024); } \
        if (lw == 0) DN_GLDS(F.CS + (size_t)itm * 256 + lane * 4, (Bn) + O_CS); } while (0)
#define DN_STORE_O(m, Ob) do { const size_t rowm = (size_t)(b * 32 + (m)) * 64; \
        _Pragma("unroll") for (int i = 0; i < 2; ++i) { const int id = lw * 128 + i * 64 + lane, rr = id >> 3, cc = id & 7; \
            const v4u ov = *(const LAS v4u*)((Ob) + rr * 128 + cc * 16); *(GAS v4u*)(F.PROJ + (rowm + rr) * NPROJ + C_DNV + h * 128 + 64 * half + cc * 8) = ov; } } while (0)
    f32x4 S[8];
#pragma unroll
    for (int kt = 0; kt < 8; ++kt) S[kt] = (f32x4){0.f, 0.f, 0.f, 0.f};
    if (w >= 4) DN_LOAD2(0, L);
    if (w < 4) __builtin_amdgcn_s_setprio(2);
#pragma unroll 2
    for (int n = 0; n < 32; ++n) {
        asm volatile("s_waitcnt vmcnt(0)" ::: "memory");
        __syncthreads();
        const int cur = n & 1; LAS unsigned char* B = L + cur * BUFS;
        if (w >= 4) {
            if (n > 0) DN_STORE_O(n - 1, L + O_O + (cur ^ 1) * 8192);
            if (n < 31) DN_LOAD2(n + 1, L + (cur ^ 1) * BUFS);
        } else {
            const LAS float* cs = (const LAS float*)(B + O_CS);
            pg8::bf16x8 Sb[4];
#pragma unroll
            for (int kk = 0; kk < 4; ++kk) Sb[kk] = packB(S[2 * kk], S[2 * kk + 1]);
            pg8::bf16x8 Rb[2];
            {   f32x4 KS[4];
#pragma unroll
                for (int mt = 0; mt < 4; ++mt) { KS[mt] = (f32x4){0.f, 0.f, 0.f, 0.f}; const int rb = 16 * mt + l15;
#pragma unroll
                    for (int kk = 0; kk < 4; ++kk)
                        KS[mt] = __builtin_amdgcn_mfma_f32_16x16x32_bf16(*(const LAS pg8::bf16x8*)(B + O_K + rb * 256 + (((4 * kk + g4) ^ DN_FSWZ(l15)) << 4)), Sb[kk], KS[mt], 0, 0, 0); }
#pragma unroll
                for (int mt = 0; mt < 4; ++mt) { const f32x4 eg = *(const LAS f32x4*)(cs + 16 * mt + 4 * g4), bt = *(const LAS f32x4*)(cs + 64 + 16 * mt + 4 * g4);
#pragma unroll
                    for (int e = 0; e < 4; ++e) { const float vf = bf2f(*(const LAS bf16*)(B + O_V + (16 * mt + 4 * g4 + e) * 128 + (16 * w + l15) * 2)); KS[mt][e] = bt[e] * (vf - eg[e] * KS[mt][e]); } }
                Rb[0] = packB(KS[0], KS[1]); Rb[1] = packB(KS[2], KS[3]); }
            pg8::bf16x8 Vb[2], Db[2];
            {   f32x4 VN[4];
#pragma unroll
                for (int mt = 0; mt < 4; ++mt) { VN[mt] = (f32x4){0.f, 0.f, 0.f, 0.f}; const int rb = 16 * mt + l15;
#pragma unroll
                    for (int k2 = 0; k2 < 2; ++k2) if (k2 <= (mt >> 1))
                        VN[mt] = __builtin_amdgcn_mfma_f32_16x16x32_bf16(*(const LAS pg8::bf16x8*)(B + O_T + rb * 128 + (((4 * k2 + g4) ^ ((rb >> 1) & 7)) << 4)), Rb[k2], VN[mt], 0, 0, 0); }
                Vb[0] = packB(VN[0], VN[1]); Vb[1] = packB(VN[2], VN[3]);
                const f32x4 d0 = *(const LAS f32x4*)(cs + 128 + 4 * g4), d1 = *(const LAS f32x4*)(cs + 128 + 16 + 4 * g4), d2 = *(const LAS f32x4*)(cs + 128 + 32 + 4 * g4), d3 = *(const LAS f32x4*)(cs + 128 + 48 + 4 * g4);
                Db[0] = packB(VN[0] * d0, VN[1] * d1); Db[1] = packB(VN[2] * d2, VN[3] * d3); }
            LAS unsigned char* Ob = L + O_O + cur * 8192;
#pragma unroll
            for (int mt = 0; mt < 4; ++mt) { f32x4 qs = {0.f, 0.f, 0.f, 0.f}; const int rb = 16 * mt + l15;
#pragma unroll
                for (int kk = 0; kk < 4; ++kk)
                    qs = __builtin_amdgcn_mfma_f32_16x16x32_bf16(*(const LAS pg8::bf16x8*)(B + O_Q + rb * 256 + (((4 * kk + g4) ^ DN_FSWZ(l15)) << 4)), Sb[kk], qs, 0, 0, 0);
                const f32x4 eg = *(const LAS f32x4*)(cs + 16 * mt + 4 * g4);
                f32x4 oc = eg * qs;
#pragma unroll
                for (int k2 = 0; k2 < 2; ++k2) if (k2 <= (mt >> 1))
                    oc = __builtin_amdgcn_mfma_f32_16x16x32_bf16(*(const LAS pg8::bf16x8*)(B + O_A + rb * 128 + (((4 * k2 + g4) ^ ((rb >> 1) & 7)) << 4)), Vb[k2], oc, 0, 0, 0);
                const unsigned p01 = pk2(oc[0], oc[1]), p23 = pk2(oc[2], oc[3]);
                LAS unsigned char* op = Ob + (16 * mt + 4 * g4) * 128 + (16 * w + l15) * 2;
                *(LAS bf16*)(op) = (bf16)(p01 & 0xffffu); *(LAS bf16*)(op + 128) = (bf16)(p01 >> 16); *(LAS bf16*)(op + 256) = (bf16)(p23 & 0xffffu); *(LAS bf16*)(op + 384) = (bf16)(p23 >> 16); }
            const float EGL = cs[192];
#pragma unroll
            for (int kt = 0; kt < 8; ++kt) { S[kt] = S[kt] * EGL;
#pragma unroll
                for (int k2 = 0; k2 < 2; ++k2) { const int c1 = 32 * k2 + 4 * g4 + trq, c2 = c1 + 16;
                    const v4i16_t t1 = vtr(B + O_K + c1 * 256 + (((4 * (kt >> 1) + trp) ^ DN_FSWZ(c1 & 15)) << 4) + 8 * (kt & 1)), t2 = vtr(B + O_K + c2 * 256 + (((4 * (kt >> 1) + trp) ^ DN_FSWZ(c2 & 15)) << 4) + 8 * (kt & 1));
                    const pg8::bf16x8 af = {t1[0], t1[1], t1[2], t1[3], t2[0], t2[1], t2[2], t2[3]};
                    S[kt] = __builtin_amdgcn_mfma_f32_16x16x32_bf16(af, Db[k2], S[kt], 0, 0, 0); } }
        }
    }
    __builtin_amdgcn_s_setprio(0);
    __syncthreads();
    if (w >= 4) DN_STORE_O(31, L + O_O + 8192);
#undef DN_LOAD2
#undef DN_STORE_O
#undef DN_GLDS
#undef DN_FSWZ
}
__device__ __forceinline__ void p2_post(Frame& F, int widx, int nwv) {
    const int lane = F.lane, h = lane >> 4, ch = lane & 15;
    const f32x4 nw0 = *(const GAS f32x4*)(F.dn_norm_w + ch * 8), nw1 = *(const GAS f32x4*)(F.dn_norm_w + ch * 8 + 4);
    const float nwv_[8] = {nw0.x, nw0.y, nw0.z, nw0.w, nw1.x, nw1.y, nw1.z, nw1.w};
    float l0, l1, l2; v4u a, bq, cq, z, zdn, od;
#define POST_LOAD(row_) do { const bf16* bs_ = F.PROJ + (size_t)(row_) * NPROJ; const float* lp_ = F.LSE + (size_t)(row_) * 12 + h; l0 = lp_[0]; l1 = lp_[4]; l2 = lp_[8]; \
        a = *(const GAS v4u*)(bs_ + C_SQ + h * 128 + ch * 8); bq = *(const GAS v4u*)(bs_ + C_SQ + 512 + h * 128 + ch * 8); cq = *(const GAS v4u*)(bs_ + C_SQ + 1024 + h * 128 + ch * 8); \
        z = *(const GAS v4u*)(bs_ + C_SZ + h * 128 + ch * 8); zdn = *(const GAS v4u*)(bs_ + C_DNZ + h * 128 + ch * 8); od = *(const GAS v4u*)(bs_ + C_DNV + h * 128 + ch * 8); } while (0)
    if (widx < M) POST_LOAD(widx);
    for (int row = widx; row < M; row += nwv) {
        const float mx = fmaxf(l0, fmaxf(l1, l2));
        float w0 = __builtin_amdgcn_exp2f(l0 - mx), w1 = __builtin_amdgcn_exp2f(l1 - mx), w2 = __builtin_amdgcn_exp2f(l2 - mx);
        const float inv = __builtin_amdgcn_rcpf(w0 + w1 + w2); w0 *= inv; w1 *= inv; w2 *= inv;
        const unsigned aa[4] = {a.x, a.y, a.z, a.w}, bb[4] = {bq.x, bq.y, bq.z, bq.w}, cc[4] = {cq.x, cq.y, cq.z, cq.w}, zz[4] = {z.x, z.y, z.z, z.w};
        const unsigned dd[4] = {od.x, od.y, od.z, od.w}, zq[4] = {zdn.x, zdn.y, zdn.z, zdn.w};
        if (row + nwv < M) POST_LOAD(row + nwv);
        unsigned oo[4];
#pragma unroll
        for (int e = 0; e < 4; ++e) {
            const float lo = (w0 * bf_lo(aa[e]) + w1 * bf_lo(bb[e]) + w2 * bf_lo(cc[e])) * siluf_(bf_lo(zz[e]));
            const float hi = (w0 * bf_hi(aa[e]) + w1 * bf_hi(bb[e]) + w2 * bf_hi(cc[e])) * siluf_(bf_hi(zz[e]));
            oo[e] = pk2(lo, hi); }
        float ss = 0.f;
#pragma unroll
        for (int e = 0; e < 4; ++e) { const float x0 = bf_lo(dd[e]), x1 = bf_hi(dd[e]); ss += x0 * x0 + x1 * x1; }
        ss = row16_sum(ss);
        const float rstd = __builtin_amdgcn_rsqf(ss * (1.f / 128.f) + EPS);
        unsigned on[4];
#pragma unroll
        for (int e = 0; e < 4; ++e) on[e] = pk2((bf_lo(dd[e]) * rstd) * nwv_[2 * e] * siluf_(bf_lo(zq[e])), (bf_hi(dd[e]) * rstd) * nwv_[2 * e + 1] * siluf_(bf_hi(zq[e])));
        *(GAS v4u*)(F.OSWA + (size_t)row * 512 + h * 128 + ch * 8) = (v4u){oo[0], oo[1], oo[2], oo[3]};
        *(GAS v4u*)(F.ODN + (size_t)row * 512 + h * 128 + ch * 8) = (v4u){on[0], on[1], on[2], on[3]};
    }
#undef POST_LOAD
}

struct Args { const float* in[12]; float* out; unsigned char* ws; int ph_lo, ph_hi; };
__global__ void __launch_bounds__(NWAVES * 64, 2) fwd_kernel(Args args) {
    extern __shared__ __attribute__((aligned(16))) unsigned char lds[];
    Frame F;
    F.lds = (LAS unsigned char*)lds;
    F.MISC = (volatile LAS unsigned*)(F.lds + MISC_OFF);
    F.tid = threadIdx.x; F.lane = F.tid & 63; F.wave = __builtin_amdgcn_readfirstlane(F.tid >> 6);
    F.G = gridDim.x; { const int bx = blockIdx.x; F.vcu = (F.G % 8 == 0) ? (bx % 8) * (F.G / 8) + bx / 8 : bx; }
    unsigned char* ws = args.ws;
    F.ctl = (gu32*)(ws + WS_CTL);
    F.x = args.in[0]; F.norm_w = args.in[1]; F.w_in = args.in[2]; F.conv_w = args.in[3]; F.a_log = args.in[4]; F.dt_bias = args.in[5]; F.dn_norm_w = args.in[6];
    F.q_norm_w = args.in[7]; F.k_norm_w = args.in[8]; F.w_bdn = args.in[9]; F.w_bswa = args.in[10]; F.w_out = args.in[11]; F.out = args.out;
    F.WinT = (bf16*)(ws + WS_WIN); F.WgT = (bf16*)(ws + WS_WG); F.WdnT = (bf16*)(ws + WS_WDN); F.WswaT = (bf16*)(ws + WS_WSWA); F.WoutT = (bf16*)(ws + WS_WOUT);
    F.H = (bf16*)args.out; F.PROJ = (bf16*)(ws + WS_PROJ); F.BG = (float*)(ws + WS_BG); F.ROPE = (float*)(ws + WS_ROPE); F.LSE = (float*)(ws + WS_LSE); F.ODN = (bf16*)((unsigned char*)args.out + OUT_ODN); F.OSWA = (bf16*)((unsigned char*)args.out + OUT_OSWA);
    F.LT = (float*)((unsigned char*)args.out + OUT_LT); F.CS = (float*)((unsigned char*)args.out + OUT_CS); F.AIMG = (bf16*)((unsigned char*)args.out + OUT_A); F.HALO = (bf16*)((unsigned char*)args.out + OUT_HALO);
    for (int u = F.tid; u < (LDS_BYTES - LDSCTL_OFF) / 4; u += NWAVES * 64) ((LAS unsigned*)(F.lds + LDSCTL_OFF))[u] = 0u;
    __syncthreads();
    XcdBarrier bar = xcd_barrier_post((unsigned*)(F.ctl + CW_BAR), F.MISC + 8);
    const int lo = args.ph_lo, hi = args.ph_hi;
#define IN(k) (lo <= (k) && (k) < hi)
#define BOTH(k) (IN(k) && IN((k) + 1))
#define GRID_BAR() xcd_barrier(bar)

    if (IN(0)) { p0_prologue(F); if (BOTH(0)) GRID_BAR(); }

    if (IN(1)) {
        pg8::Gemm g{F.H, F.WinT, M, NPROJ, D, D, D}; pg8::StaticOrder S; S.init(M, NPROJ, F.G, (int)blockIdx.x);
        pg8::EpiBf<0> E{F.PROJ, nullptr, nullptr, NPROJ, F.HALO, F.q_norm_w, F.k_norm_w, F.ROPE, (LAS float*)(F.lds + 131072)};
        pg8::gemm_phase<pg8::EpiBf<0>, pg8::StaticOrder, true, true>(F.lds + RING_OFF, g, S, E);
        if (BOTH(1)) GRID_BAR();
    }
    if (IN(2)) {
        { const int base = F.vcu * 4;
            v4u raw[11]; f32x4 cw[4][2]; float gv = 0.f, bt = 0.f;
            prepA_load(F, base, raw, cw, gv, bt);
            asm volatile("s_waitcnt vmcnt(0)" ::: "memory");
            __syncthreads();
            prepA_conv(F, base, raw, cw, gv, bt, 0);
            prepA_load(F, base + 1, raw, cw, gv, bt);
#pragma unroll 1
            for (int j = 0; j < 4; ++j) {
                asm volatile("s_waitcnt vmcnt(0)" ::: "memory");
                __syncthreads();
                if (j < 3) { prepA_conv(F, base + j + 1, raw, cw, gv, bt, (j + 1) & 1);
                    if (j < 2) prepA_load(F, base + j + 2, raw, cw, gv, bt); }
                prepA_mfma(F, base + j, j & 1);
            }
            asm volatile("s_waitcnt vmcnt(0)" ::: "memory");
            __syncthreads();
            dn_prep_B4(F, base);
            asm volatile("s_waitcnt vmcnt(0)" ::: "memory");
            __syncthreads();
        }
        if (BOTH(2)) GRID_BAR();
    }
    if (IN(3)) {
        if (F.vcu < 64) dn_scan2(F, F.vcu);
        else { p2_attn_run(F, F.vcu - 64); __syncthreads();
            tr_run(F, TR_I_IN, TR_NITEMS, (LAS float*)(F.lds + RING_OFF + F.wave * 8704), (F.vcu - 64) * NWAVES + F.wave, (F.G - 64) * NWAVES); }
        if (BOTH(3)) GRID_BAR();
    }
    if (IN(4)) { p2_post(F, F.vcu * NWAVES + F.wave, F.G * NWAVES); if (BOTH(4)) GRID_BAR(); }
    if (IN(5)) {
        struct P3Sched { int pm, pn; bool ok; const bf16 *H, *WgT, *WdnT, *WswaT, *ODN, *OSWA; bf16* PJ;
            __device__ __forceinline__ bool next(int i, pg8::UnitD& u) const {
                if (!ok || i >= 4) return false;
                u.pm = pm; u.pn = pn;
                const size_t prow = (size_t)pm * 256; bf16* scr1 = PJ + PJ_SCR1 / 2; bf16* scr2 = PJ + PJ_SCR2 / 2; bf16* scr3 = PJ + PJ_SCR3 / 2; bf16* mrg = PJ + PJ_MERGED / 2;
                if (i == 0)      { u.A = (const char*)(H + prow * D); u.lda2 = D * 2; u.B = (const char*)(WgT + (size_t)pn * 256 * D); u.ldb2 = D * 2; u.nt = 16; u.mode = 1; u.O = scr1; u.S1 = nullptr; u.S2 = nullptr; }
                else if (i == 1) { u.A = (const char*)(ODN + prow * 512); u.lda2 = 512 * 2; u.B = (const char*)(WdnT + (size_t)pn * 256 * 512); u.ldb2 = 512 * 2; u.nt = 8; u.mode = 2; u.O = scr2; u.S1 = scr1; u.S2 = nullptr; }
                else if (i == 2) { u.A = (const char*)(H + prow * D); u.lda2 = D * 2; u.B = (const char*)(WgT + (size_t)(1024 + pn * 256) * D); u.ldb2 = D * 2; u.nt = 16; u.mode = 1; u.O = scr3; u.S1 = nullptr; u.S2 = nullptr; }
                else             { u.A = (const char*)(OSWA + prow * 512); u.lda2 = 512 * 2; u.B = (const char*)(WswaT + (size_t)pn * 256 * 512); u.ldb2 = 512 * 2; u.nt = 8; u.mode = 3; u.O = mrg; u.S1 = scr3; u.S2 = scr2; }
                return true; } };
        pg8::StaticOrder S0; S0.init(M, D, F.G, (int)blockIdx.x); pg8::Unit u0; const bool ok = S0.next(0, u0);
        P3Sched S{u0.pm, u0.pn, ok, F.H, F.WgT, F.WdnT, F.WswaT, F.ODN, F.OSWA, F.PROJ};
        pg8::gemm_stream<P3Sched, true>(F.lds + RING_OFF, S, D);
        if (BOTH(5)) GRID_BAR();
    }
    if (IN(6)) {
        pg8::Gemm g{F.PROJ + PJ_MERGED / 2, F.WoutT, M, D, D, D, D}; pg8::StaticOrder S; S.init(M, D, F.G, (int)blockIdx.x);
        pg8::EpiRes E{F.x, F.out, D};
        pg8::gemm_phase<pg8::EpiRes, pg8::StaticOrder, false, true>(F.lds + RING_OFF, g, S, E);
    }
#undef IN
#undef BOTH
#undef GRID_BAR
}

#ifndef N_LAUNCHES
#define N_LAUNCHES 1
#endif
extern "C" void kernel_launch(void* const* d_in, const int* in_sizes, int n_in, void* d_out, int out_size, void* d_ws, size_t ws_size, hipStream_t stream) {
    static int grid = 0;
    if (grid == 0) {
        if (n_in != 12 || in_sizes[0] != M * D || out_size != M * D || ws_size < WS_END) { fprintf(stderr, "kernel_launch: unexpected shapes (n_in %d, in0 %d, out %d, ws %zu); nothing launched\n", n_in, n_in > 0 ? in_sizes[0] : -1, out_size, ws_size); grid = -1; return; }
        int dev = 0, cus = 0, per_cu = 0;
        if (hipGetDevice(&dev) != hipSuccess || hipDeviceGetAttribute(&cus, hipDeviceAttributeMultiprocessorCount, dev) != hipSuccess) { grid = -1; return; }
        if (hipFuncSetAttribute((const void*)fwd_kernel, hipFuncAttributeMaxDynamicSharedMemorySize, LDS_BYTES) != hipSuccess) { fprintf(stderr, "kernel_launch: hipFuncSetAttribute failed\n"); grid = -1; return; }
        if (hipOccupancyMaxActiveBlocksPerMultiprocessor(&per_cu, (const void*)fwd_kernel, NWAVES * 64, LDS_BYTES) != hipSuccess || per_cu < 1) { fprintf(stderr, "kernel_launch: occupancy query says %d blocks per CU; nothing launched\n", per_cu); (void)hipGetLastError(); grid = -1; return; }
        if (cus != 256) { fprintf(stderr, "kernel_launch: built for a 256-CU device (got %d); nothing launched\n", cus); grid = -1; return; }
        grid = cus;
    }
    if (grid < 0) return;
    (void)hipMemsetAsync((char*)d_ws + WS_CTL, 0, CTL_ZERO_BYTES, stream);
    Args a{};
    for (int i = 0; i < 12; ++i) a.in[i] = (const float*)d_in[i];
    a.out = (float*)d_out; a.ws = (unsigned char*)d_ws;
    constexpr int NPH = 7;
#if N_LAUNCHES == 1
    a.ph_lo = 0; a.ph_hi = NPH;
    hipLaunchKernelGGL(fwd_kernel, dim3(grid), dim3(NWAVES * 64), LDS_BYTES, stream, a);
#else
    for (int p = 0; p < NPH; ++p) { a.ph_lo = p; a.ph_hi = p + 1; hipLaunchKernelGGL(fwd_kernel, dim3(grid), dim3(NWAVES * 64), LDS_BYTES, stream, a); }
#endif
}
```

```cpp
#include <hip/hip_runtime.h>
#include <cstdio>
#include <cstdint>
namespace pg8 {
#define PG8_LAS __attribute__((address_space(3)))
typedef unsigned short bf16_t;
typedef short bf16x8 __attribute__((ext_vector_type(8)));
typedef float f32x4 __attribute__((ext_vector_type(4)));
typedef unsigned u32x4 __attribute__((ext_vector_type(4)));
constexpr int BM = 256, BK = 64, HALF = 128, HTB = HALF * BK * 2  , STAGE_BYTES = 8 * HTB, NXCD = 8, WGM = 4;

__host__ __device__ __forceinline__ int lds_byte(int r, int c) { const int st = (r >> 4) * 2 + (c >> 5), rr = r & 15, cc = c & 31, ob = rr * 64 + cc * 2; return st * 1024 + (ob ^ (((ob >> 9) & 1) << 5)); }
__host__ __device__ __forceinline__ void stage_rc(int b, int& R, int& C) { const int st = b / 1024, sb = b % 1024, swz = sb ^ (((sb >> 9) & 1) << 5); R = (st >> 1) * 16 + swz / 64; C = (st & 1) * 32 + (swz % 64) / 2; }
__host__ __device__ __forceinline__ int perm32(int rho) { const int n = rho >> 4, i = rho & 15; return 8 * (i >> 2) + 4 * n + (i & 3); }

struct Unit { int pm, pn; };
struct Gemm { const bf16_t* A; const bf16_t* Bt; int M, N, K, lda, ldb; };

struct StaticOrder {
    int nM, nN, nwg, G, c;
    __host__ __device__ void init(int M, int N, int G_, int c_) { nM = M / BM; nN = N / BM; nwg = nM * nN; G = G_; c = c_; }
    __host__ __device__ bool next(int i, Unit& u) const {
        const long L = (long)i * G + c; if (L >= nwg) return false;
        int wgid = (int)L; { const int q = nwg / NXCD, r = nwg % NXCD, xcd = wgid % NXCD, off = wgid / NXCD; wgid = (xcd < r ? xcd * (q + 1) : r * (q + 1) + (xcd - r) * q) + off; }
        const int nig = WGM * nN, gid = wgid / nig, fm = gid * WGM, gsz = (nM - fm) < WGM ? (nM - fm) : WGM;
        u.pm = fm + ((wgid % nig) % gsz); u.pn = (wgid % nig) / gsz; return true;
    }
    __device__ __forceinline__ void a_ready(const Unit&) const {}
    __device__ __forceinline__ void done(const Unit&) const {}
};

typedef float f32x2_t __attribute__((ext_vector_type(2))); typedef __bf16 bf16x2_t __attribute__((ext_vector_type(2)));
__device__ __forceinline__ unsigned cvt_pk_bf16(float lo, float hi) { const f32x2_t v = {lo, hi}; const bf16x2_t b = __builtin_convertvector(v, bf16x2_t); return __builtin_bit_cast(unsigned, b); }
__device__ __forceinline__ float bf_lo(unsigned w) { return __builtin_bit_cast(float, w << 16); }
__device__ __forceinline__ float bf_hi(unsigned w) { return __builtin_bit_cast(float, w & 0xffff0000u); }
__device__ __forceinline__ float sigmoidf_(float x) { return __builtin_amdgcn_rcpf(1.0f + __expf(-x)); }

template <int MODE> struct EpiBf {
    static constexpr bool PERM = true, AFTER_DRAIN = false, PRELOAD = false;
    bf16_t* O; const bf16_t* S1; const bf16_t* S2; int ldc; bf16_t* halo;
    const float* qnw; const float* knw; const float* rope; PG8_LAS float* xch;
    __device__ __forceinline__ void operator()(const f32x4 (&acc)[2][2][4][2], const Unit& u, int wr, int wc, int fr, int fq) const {
        const int row0 = u.pm * BM + wr * 64 + fr; const int col0 = u.pn * BM + wc * 32 + 8 * fq;
        if (MODE == 0 && qnw != nullptr && u.pn >= 8 && u.pn < 20) {
            const int which = u.pn >= 14 ? 1 : 0, g = (u.pn - (which ? 14 : 8)) >> 1;
#pragma unroll
            for (int ai = 0; ai < 2; ++ai)
#pragma unroll
                for (int mp = 0; mp < 2; ++mp) { float r2[2];
#pragma unroll
                    for (int mm = 0; mm < 2; ++mm) { float sq[2];
#pragma unroll
                        for (int bj = 0; bj < 2; ++bj) { const f32x4 v0 = acc[ai][bj][2 * mp + mm][0], v1 = acc[ai][bj][2 * mp + mm][1];
                            sq[bj] = (v0[0] * v0[0] + v0[1] * v0[1]) + (v0[2] * v0[2] + v0[3] * v0[3]) + (v1[0] * v1[0] + v1[1] * v1[1]) + (v1[2] * v1[2] + v1[3] * v1[3]); }
                        const auto t = __builtin_amdgcn_permlane32_swap(__float_as_uint(sq[0]), __float_as_uint(sq[1]), false, false); r2[mm] = __uint_as_float(t[0]) + __uint_as_float(t[1]); }
                    const auto t = __builtin_amdgcn_permlane16_swap(__float_as_uint(r2[0]), __float_as_uint(r2[1]), false, false);
                    xch[(ai * HALF + wr * 64 + (2 * mp + (fq & 1)) * 16 + fr) * 8 + (fq >> 1) * 4 + wc] = __uint_as_float(t[0]) + __uint_as_float(t[1]); }
            asm volatile("s_waitcnt lgkmcnt(0)" ::: "memory"); __builtin_amdgcn_s_barrier(); asm volatile("" ::: "memory");
            const float* nwb = (which ? knw : qnw) + g * 128;
            f32x4 w0, w1;
            if (wc == 0) { const f32x4 wa = *(const f32x4*)(nwb + 4 * fq), wb = *(const f32x4*)(nwb + 16 + 4 * fq); w0 = (f32x4){wa[0], wb[0], wa[1], wb[1]}; w1 = (f32x4){wa[2], wb[2], wa[3], wb[3]}; }
            else { w0 = *(const f32x4*)(nwb + wc * 32 + fq * 8); w1 = *(const f32x4*)(nwb + wc * 32 + fq * 8 + 4); }
            f32x4 c4 = {1.f, 1.f, 1.f, 1.f}, s4 = {0.f, 0.f, 0.f, 0.f}, cd4 = c4, sd4 = s4;
            if (wc == 0) {
                { const f32x4* rp = (const f32x4*)(rope + ((size_t)(row0 & 2047) * 16 + 4 * fq) * 2); const f32x4 r0 = rp[0], r1 = rp[1]; c4 = (f32x4){r0[0], r0[2], r1[0], r1[2]}; s4 = (f32x4){r0[1], r0[3], r1[1], r1[3]}; }
                { const f32x4* rp = (const f32x4*)(rope + ((size_t)16 * 16 + 4 * fq) * 2); const f32x4 r0 = rp[0], r1 = rp[1]; cd4 = (f32x4){r0[0], r0[2], r1[0], r1[2]}; sd4 = (f32x4){r0[1], r0[3], r1[1], r1[3]}; }
            }
#pragma unroll
            for (int ai = 0; ai < 2; ++ai) {
#pragma unroll
                for (int m = 0; m < 4; ++m) { const int row = row0 + ai * HALF + m * 16; const size_t roff = (size_t)row * ldc + col0;
#pragma unroll
                    for (int bj = 0; bj < 2; ++bj) { const f32x4 pq = *(const PG8_LAS f32x4*)(xch + (ai * HALF + wr * 64 + m * 16 + fr) * 8 + bj * 4);
                        const float r = __builtin_amdgcn_rsqf(((pq[0] + pq[1]) + (pq[2] + pq[3])) * (1.f / 128.f) + 1e-6f);
                        f32x4 v0 = (acc[ai][bj][m][0] * r) * w0, v1 = (acc[ai][bj][m][1] * r) * w1;
                        {
                            const f32x4 t0 = v0, t1 = v1;
                            v0[0] = t0[0] * c4[0] - t0[1] * s4[0]; v0[1] = t0[1] * c4[0] + t0[0] * s4[0]; v0[2] = t0[2] * c4[1] - t0[3] * s4[1]; v0[3] = t0[3] * c4[1] + t0[2] * s4[1];
                            v1[0] = t1[0] * c4[2] - t1[1] * s4[2]; v1[1] = t1[1] * c4[2] + t1[0] * s4[2]; v1[2] = t1[2] * c4[3] - t1[3] * s4[3]; v1[3] = t1[3] * c4[3] + t1[2] * s4[3]; }
                        u32x4 w; w.x = cvt_pk_bf16(v0[0], v0[1]); w.y = cvt_pk_bf16(v0[2], v0[3]); w.z = cvt_pk_bf16(v1[0], v1[1]); w.w = cvt_pk_bf16(v1[2], v1[3]);
                        *(u32x4*)(O + roff + bj * HALF) = w; }
                    if (!(ai == 1 && m == 3)) {
#pragma unroll
                        for (int st = 0; st < 5; ++st) if (st == 0 || m == 3) { const f32x4 nc = c4 * cd4 - s4 * sd4, ns = s4 * cd4 + c4 * sd4; c4 = nc; s4 = ns; } } } }
            return;
        }
#pragma unroll
        for (int ai = 0; ai < 2; ++ai) {
            u32x4 s1v[4][2], s2v[4][2];
            if (MODE >= 2) {
#pragma unroll
                for (int m = 0; m < 4; ++m)
#pragma unroll
                    for (int bj = 0; bj < 2; ++bj) { const size_t ro = (size_t)(row0 + ai * HALF + m * 16) * ldc + col0 + bj * HALF;
                        s1v[m][bj] = *(const u32x4*)(S1 + ro); if (MODE == 3) s2v[m][bj] = *(const u32x4*)(S2 + ro); } }
#pragma unroll
            for (int m = 0; m < 4; ++m) { const size_t roff = (size_t)(row0 + ai * HALF + m * 16) * ldc + col0;
#pragma unroll
                for (int bj = 0; bj < 2; ++bj) { f32x4 v0 = acc[ai][bj][m][0], v1 = acc[ai][bj][m][1];
                    if (MODE == 1) {
#pragma unroll
                        for (int e = 0; e < 4; ++e) { v0[e] = sigmoidf_(v0[e]); v1[e] = sigmoidf_(v1[e]); } }
                    if (MODE >= 2) { const u32x4 s = s1v[m][bj];
                        v0[0] *= bf_lo(s.x); v0[1] *= bf_hi(s.x); v0[2] *= bf_lo(s.y); v0[3] *= bf_hi(s.y); v1[0] *= bf_lo(s.z); v1[1] *= bf_hi(s.z); v1[2] *= bf_lo(s.w); v1[3] *= bf_hi(s.w); }
                    if (MODE == 3) { const u32x4 s = s2v[m][bj];
                        v0[0] += bf_lo(s.x); v0[1] += bf_hi(s.x); v0[2] += bf_lo(s.y); v0[3] += bf_hi(s.y); v1[0] += bf_lo(s.z); v1[1] += bf_hi(s.z); v1[2] += bf_lo(s.w); v1[3] += bf_hi(s.w); }
                    u32x4 w; w.x = cvt_pk_bf16(v0[0], v0[1]); w.y = cvt_pk_bf16(v0[2], v0[3]); w.z = cvt_pk_bf16(v1[0], v1[1]); w.w = cvt_pk_bf16(v1[2], v1[3]);
                    *(u32x4*)(O + roff + bj * HALF) = w;
                    if (MODE == 0 && m == 3) { if (halo && u.pn < 6 && fr >= 13) *(u32x4*)(halo + ((size_t)((row0 + ai * HALF + 48) >> 6) * 3 + (fr - 13)) * 1536 + col0 + bj * HALF) = w; } } } }
    }
};
struct EpiRes {
    static constexpr bool PERM = false, AFTER_DRAIN = false, PRELOAD = true;
    const float* base; float* out; int ldc;
    __device__ __forceinline__ void preload(f32x4 (&acc)[2][2][4][2], const Unit& u, int wr, int wc, int fr, int fq) const {
        const int row0 = u.pm * BM + wr * 64 + fr, col0 = u.pn * BM + wc * 32 + 4 * fq;
#pragma unroll
        for (int ai = 0; ai < 2; ++ai)
#pragma unroll
            for (int m = 0; m < 4; ++m)
#pragma unroll
                for (int bj = 0; bj < 2; ++bj)
#pragma unroll
                    for (int n = 0; n < 2; ++n) acc[ai][bj][m][n] = *(const f32x4*)(base + (size_t)(row0 + ai * HALF + m * 16) * ldc + col0 + bj * HALF + n * 16);
    }
    __device__ __forceinline__ void operator()(const f32x4 (&acc)[2][2][4][2], const Unit& u, int wr, int wc, int fr, int fq) const {
        const int row0 = u.pm * BM + wr * 64 + fr, col0 = u.pn * BM + wc * 32 + 4 * fq;
#pragma unroll
        for (int ai = 0; ai < 2; ++ai)
#pragma unroll
            for (int m = 0; m < 4; ++m) { const size_t roff = (size_t)(row0 + ai * HALF + m * 16) * ldc + col0;
#pragma unroll
                for (int bj = 0; bj < 2; ++bj)
#pragma unroll
                    for (int n = 0; n < 2; ++n) *(f32x4*)(out + roff + bj * HALF + n * 16) = acc[ai][bj][m][n]; }
    }
};

template <class Epi, class Sched, bool ALIGN_EPI = false, bool SP2 = false>
__device__ __forceinline__ void gemm_phase(PG8_LAS unsigned char* lds, const Gemm g, const Sched& S, const Epi& E) {
    const int tid = threadIdx.x, wid = __builtin_amdgcn_readfirstlane(tid >> 6), lane = tid & 63, wr = wid >> 2, wc = wid & 3, fr = lane & 15, fq = lane >> 4;
    const int K = g.K, nt = K / BK;
    unsigned voffA[2], voffB[2];
#pragma unroll
    for (int i = 0; i < 2; ++i) { int R, C; stage_rc(tid * 16 + i * 8192, R, C); const int Rb = Epi::PERM ? ((R & ~31) + perm32(R & 31)) : R;
        voffA[i] = (unsigned)(R * g.lda + C) * 2u; voffB[i] = (unsigned)(Rb * g.ldb + C) * 2u; }
    const size_t kstep = (size_t)(BK * 2);
    const size_t hstepA = (size_t)HALF * g.lda * 2, hstepB = (size_t)HALF * g.ldb * 2;
    const size_t tstepA = 2 * hstepA, tstepB = 2 * hstepB;
    const unsigned ldsw = (unsigned)wid * 1024u;
    const int aoff = lds_byte(wr * 64 + fr, fq * 8), boff = lds_byte(wc * 32 + fr, fq * 8);
#define PG8_SA(b, h) (((b) * 2 + (h)) * HTB)
#define PG8_SB(b, h) ((4 + (b) * 2 + (h)) * HTB)
#define PG8_STAGE(bufoff, gbase, voff) do { _Pragma("unroll") for (int _i = 0; _i < 2; ++_i) \
        __builtin_amdgcn_global_load_lds((const unsigned*)((const char*)(gbase) + (voff)[_i]), (PG8_LAS unsigned*)(lds + (bufoff) + ldsw + _i * 8192), 16, 0, 0); } while (0)
#define PG8_LDA(dst, b, h) do { _Pragma("unroll") for (int m = 0; m < 4; ++m) _Pragma("unroll") for (int k = 0; k < 2; ++k) dst[m][k] = *(const PG8_LAS bf16x8*)(lds + PG8_SA(b, h) + aoff + m * 2048 + k * 1024); } while (0)
#define PG8_LDB(dst, b, h) do { _Pragma("unroll") for (int n = 0; n < 2; ++n) _Pragma("unroll") for (int k = 0; k < 2; ++k) dst[n][k] = *(const PG8_LAS bf16x8*)(lds + PG8_SB(b, h) + boff + n * 2048 + k * 1024); } while (0)
#define PG8_MMA(ai, bj, At, Bt) do { __builtin_amdgcn_s_setprio(1); _Pragma("unroll") for (int m = 0; m < 4; ++m) _Pragma("unroll") for (int n = 0; n < 2; ++n) _Pragma("unroll") for (int k = 0; k < 2; ++k) \
        acc[ai][bj][m][n] = __builtin_amdgcn_mfma_f32_16x16x32_bf16(Bt[n][k], At[m][k], acc[ai][bj][m][n], 0, 0, 0); __builtin_amdgcn_s_setprio(0); } while (0)
#define PG8_WAIT_V(n) asm volatile("s_waitcnt vmcnt(" #n ")" ::: "memory")
#define PG8_WAIT_L(n) asm volatile("s_waitcnt lgkmcnt(" #n ")" ::: "memory")
#define PG8_BAR __builtin_amdgcn_s_barrier()
#define PG8_SCHED __builtin_amdgcn_sched_barrier(0)
    Unit cur, nxt; int ui = 0;
    if (!S.next(0, cur)) return;
    f32x4 acc[2][2][4][2];
    if constexpr (Epi::PRELOAD) E.preload(acc, cur, wr, wc, fr, fq);
    else {
#pragma unroll
    for (int a = 0; a < 2; ++a)
#pragma unroll
        for (int b = 0; b < 2; ++b)
#pragma unroll
            for (int m = 0; m < 4; ++m)
#pragma unroll
                for (int n = 0; n < 2; ++n) acc[a][b][m][n] = (f32x4){0.f, 0.f, 0.f, 0.f};
    }
    bf16x8 At[4][2], B0[2][2], B1[2][2];
    const char* cA = (const char*)g.A + (size_t)cur.pm * tstepA; const char* cB = (const char*)g.Bt + (size_t)cur.pn * tstepB;
    S.a_ready(cur);
    if constexpr (SP2) {
        PG8_STAGE(PG8_SB(0, 0), cB, voffB); PG8_STAGE(PG8_SB(0, 1), cB + hstepB, voffB); PG8_STAGE(PG8_SA(0, 0), cA, voffA); PG8_STAGE(PG8_SA(0, 1), cA + hstepA, voffA);
        if (wr == 1) PG8_BAR;
        PG8_WAIT_V(2); PG8_BAR;
        PG8_STAGE(PG8_SB(1, 0), cB + kstep, voffB); PG8_STAGE(PG8_SA(1, 0), cA + kstep, voffA); PG8_STAGE(PG8_SB(1, 1), cB + hstepB + kstep, voffB);
        PG8_WAIT_V(6); PG8_BAR;
    } else {
        PG8_STAGE(PG8_SB(0, 0), cB, voffB); PG8_STAGE(PG8_SA(0, 0), cA, voffA); PG8_STAGE(PG8_SB(0, 1), cB + hstepB, voffB); PG8_STAGE(PG8_SA(0, 1), cA + hstepA, voffA);
        if (wr == 1) PG8_BAR;
        PG8_WAIT_V(4); PG8_BAR;
        PG8_STAGE(PG8_SB(1, 0), cB + kstep, voffB); PG8_STAGE(PG8_SA(1, 0), cA + kstep, voffA); PG8_STAGE(PG8_SB(1, 1), cB + hstepB + kstep, voffB);
        PG8_WAIT_V(6); PG8_BAR;
    }
    for (;;) {
        const bool has_next = S.next(ui + 1, nxt);
        const char* nA = has_next ? (const char*)g.A + (size_t)nxt.pm * tstepA : cA; const char* nB = has_next ? (const char*)g.Bt + (size_t)nxt.pn * tstepB : cB;
        for (int t = 0; t < nt; t += 2) {
            const bool last = (t == nt - 2);
            const char* a1 = cA + (size_t)(t + 1) * kstep;
            const char* a2 = last ? nA : cA + (size_t)(t + 2) * kstep; const char* b2 = last ? nB : cB + (size_t)(t + 2) * kstep;
            const char* a3 = a2 + kstep; const char* b3 = b2 + kstep;
            if (last && has_next) S.a_ready(nxt);
            if constexpr (SP2) {
            PG8_LDB(B0, 0, 0); PG8_LDB(B1, 0, 1); PG8_SCHED; PG8_LDA(At, 0, 0); PG8_STAGE(PG8_SA(1, 1), a1 + hstepA, voffA);
            PG8_WAIT_V(8); PG8_WAIT_L(0); PG8_BAR; PG8_MMA(0, 0, At, B0); PG8_MMA(0, 1, At, B1); PG8_BAR; PG8_SCHED;
            PG8_LDA(At, 0, 1); PG8_STAGE(PG8_SB(0, 0), b2, voffB); PG8_STAGE(PG8_SB(0, 1), b2 + hstepB, voffB); PG8_STAGE(PG8_SA(0, 0), a2, voffA);
            PG8_WAIT_V(8); PG8_WAIT_L(0); PG8_BAR; PG8_MMA(1, 0, At, B0); PG8_MMA(1, 1, At, B1); PG8_BAR; PG8_SCHED;
            PG8_LDB(B0, 1, 0); PG8_LDB(B1, 1, 1); PG8_SCHED; PG8_LDA(At, 1, 0); PG8_STAGE(PG8_SA(0, 1), a2 + hstepA, voffA);
            PG8_WAIT_V(8); PG8_WAIT_L(0); PG8_BAR; PG8_MMA(0, 0, At, B0); PG8_MMA(0, 1, At, B1); PG8_BAR; PG8_SCHED;
            PG8_LDA(At, 1, 1); PG8_STAGE(PG8_SB(1, 0), b3, voffB); PG8_STAGE(PG8_SB(1, 1), b3 + hstepB, voffB); PG8_STAGE(PG8_SA(1, 0), a3, voffA);
            PG8_WAIT_V(8); PG8_WAIT_L(0); PG8_BAR; PG8_MMA(1, 0, At, B0); PG8_MMA(1, 1, At, B1); PG8_BAR; PG8_SCHED;
            } else {
            PG8_LDB(B0, 0, 0); PG8_SCHED; PG8_LDA(At, 0, 0); PG8_STAGE(PG8_SA(1, 1), a1 + hstepA, voffA);
            PG8_WAIT_L(8); PG8_BAR; PG8_WAIT_L(0); PG8_MMA(0, 0, At, B0); PG8_BAR; PG8_SCHED;
            PG8_LDB(B1, 0, 1); PG8_STAGE(PG8_SB(0, 0), b2, voffB);
            PG8_BAR; PG8_WAIT_L(0); PG8_MMA(0, 1, At, B1); PG8_BAR;
            PG8_LDA(At, 0, 1); PG8_STAGE(PG8_SA(0, 0), a2, voffA);
            PG8_BAR; PG8_WAIT_L(0); PG8_MMA(1, 0, At, B0); PG8_BAR; PG8_SCHED;
            PG8_STAGE(PG8_SB(0, 1), b2 + hstepB, voffB);
            PG8_WAIT_V(6); PG8_BAR; PG8_MMA(1, 1, At, B1); PG8_BAR;
            PG8_LDB(B0, 1, 0); PG8_SCHED; PG8_LDA(At, 1, 0); PG8_STAGE(PG8_SA(0, 1), a2 + hstepA, voffA);
            PG8_WAIT_L(8); PG8_BAR; PG8_WAIT_L(0); PG8_MMA(0, 0, At, B0); PG8_BAR; PG8_SCHED;
            PG8_LDB(B1, 1, 1); PG8_STAGE(PG8_SB(1, 0), b3, voffB);
            PG8_BAR; PG8_WAIT_L(0); PG8_MMA(0, 1, At, B1); PG8_BAR;
            PG8_LDA(At, 1, 1); PG8_STAGE(PG8_SA(1, 0), a3, voffA);
            PG8_BAR; PG8_WAIT_L(0); PG8_MMA(1, 0, At, B0); PG8_BAR; PG8_SCHED;
            PG8_STAGE(PG8_SB(1, 1), b3 + hstepB, voffB);
            PG8_WAIT_V(6); PG8_BAR; PG8_MMA(1, 1, At, B1); PG8_BAR;
            }
        }
        if constexpr (ALIGN_EPI) { if (wr == 0) PG8_BAR; }
        if constexpr (!Epi::AFTER_DRAIN) { E(acc, cur, wr, wc, fr, fq); S.done(cur); }
        if (!has_next) break;
#pragma unroll
        for (int a = 0; a < 2; ++a)
#pragma unroll
            for (int b = 0; b < 2; ++b)
#pragma unroll
                for (int m = 0; m < 4; ++m)
#pragma unroll
                    for (int n = 0; n < 2; ++n) acc[a][b][m][n] = (f32x4){0.f, 0.f, 0.f, 0.f};
        cur = nxt; cA = nA; cB = nB; ++ui;
        if constexpr (ALIGN_EPI) { if (wr == 1) PG8_BAR; }
    }
    PG8_WAIT_V(0);
    if constexpr (!ALIGN_EPI) { if (wr == 0) PG8_BAR; }
    PG8_BAR;
    if constexpr (Epi::AFTER_DRAIN) { E.fused(acc, cur, wr, wc, fr, fq, lds, wid, lane); S.done(cur); }
#undef PG8_SA
#undef PG8_SB
#undef PG8_STAGE
#undef PG8_LDA
#undef PG8_LDB
#undef PG8_MMA
#undef PG8_WAIT_V
#undef PG8_WAIT_L
#undef PG8_BAR
#undef PG8_SCHED
}

struct UnitD { const char* A; const char* B; unsigned lda2, ldb2; int nt, pm, pn, mode; bf16_t* O; const bf16_t* S1; const bf16_t* S2; };
template <class Sched, bool ALIGN_EPI>
__device__ __forceinline__ void gemm_stream(PG8_LAS unsigned char* lds, const Sched& S, int ldc) {
    const int tid = threadIdx.x, wid = __builtin_amdgcn_readfirstlane(tid >> 6), lane = tid & 63, wr = wid >> 2, wc = wid & 3, fr = lane & 15, fq = lane >> 4;
    unsigned RA[2], RB[2], CC[2];
#pragma unroll
    for (int i = 0; i < 2; ++i) { int R, C; stage_rc(tid * 16 + i * 8192, R, C); RA[i] = (unsigned)R; RB[i] = (unsigned)((R & ~31) + perm32(R & 31)); CC[i] = (unsigned)C * 2u; }
    const size_t kstep = (size_t)(BK * 2);
    const unsigned ldsw = (unsigned)wid * 1024u;
    const int aoff = lds_byte(wr * 64 + fr, fq * 8), boff = lds_byte(wc * 32 + fr, fq * 8);
#define PG8_SA(b, h) (((b) * 2 + (h)) * HTB)
#define PG8_SB(b, h) ((4 + (b) * 2 + (h)) * HTB)
#define PG8_STAGE(bufoff, gbase, voff) do { _Pragma("unroll") for (int _i = 0; _i < 2; ++_i) \
        __builtin_amdgcn_global_load_lds((const unsigned*)((const char*)(gbase) + (voff)[_i]), (PG8_LAS unsigned*)(lds + (bufoff) + ldsw + _i * 8192), 16, 0, 0); } while (0)
#define PG8_LDA(dst, b, h) do { _Pragma("unroll") for (int m = 0; m < 4; ++m) _Pragma("unroll") for (int k = 0; k < 2; ++k) dst[m][k] = *(const PG8_LAS bf16x8*)(lds + PG8_SA(b, h) + aoff + m * 2048 + k * 1024); } while (0)
#define PG8_LDB(dst, b, h) do { _Pragma("unroll") for (int n = 0; n < 2; ++n) _Pragma("unroll") for (int k = 0; k < 2; ++k) dst[n][k] = *(const PG8_LAS bf16x8*)(lds + PG8_SB(b, h) + boff + n * 2048 + k * 1024); } while (0)
#define PG8_MMA(ai, bj, At, Bt) do { __builtin_amdgcn_s_setprio(1); _Pragma("unroll") for (int m = 0; m < 4; ++m) _Pragma("unroll") for (int n = 0; n < 2; ++n) _Pragma("unroll") for (int k = 0; k < 2; ++k) \
        acc[ai][bj][m][n] = __builtin_amdgcn_mfma_f32_16x16x32_bf16(Bt[n][k], At[m][k], acc[ai][bj][m][n], 0, 0, 0); __builtin_amdgcn_s_setprio(0); } while (0)
#define PG8_WAIT_V(n) asm volatile("s_waitcnt vmcnt(" #n ")" ::: "memory")
#define PG8_WAIT_L(n) asm volatile("s_waitcnt lgkmcnt(" #n ")" ::: "memory")
#define PG8_BAR __builtin_amdgcn_s_barrier()
#define PG8_SCHED __builtin_amdgcn_sched_barrier(0)
#define PG8_VOFF(vA, vB, u) do { _Pragma("unroll") for (int _i = 0; _i < 2; ++_i) { vA[_i] = RA[_i] * (u).lda2 + CC[_i]; vB[_i] = RB[_i] * (u).ldb2 + CC[_i]; } } while (0)
    UnitD cur, nxt; int ui = 0;
    if (!S.next(0, cur)) return;
    f32x4 acc[2][2][4][2];
#pragma unroll
    for (int a = 0; a < 2; ++a)
#pragma unroll
        for (int b = 0; b < 2; ++b)
#pragma unroll
            for (int m = 0; m < 4; ++m)
#pragma unroll
                for (int n = 0; n < 2; ++n) acc[a][b][m][n] = (f32x4){0.f, 0.f, 0.f, 0.f};
    bf16x8 At[4][2], B0[2][2], B1[2][2];
    unsigned vAc[2], vBc[2], vAn[2], vBn[2];
    PG8_VOFF(vAc, vBc, cur);
    {   const char* cA = cur.A; const char* cB = cur.B; const size_t hA = (size_t)HALF * cur.lda2, hB = (size_t)HALF * cur.ldb2;
        PG8_STAGE(PG8_SB(0, 0), cB, vBc); PG8_STAGE(PG8_SB(0, 1), cB + hB, vBc); PG8_STAGE(PG8_SA(0, 0), cA, vAc); PG8_STAGE(PG8_SA(0, 1), cA + hA, vAc);
        if (wr == 1) PG8_BAR;
        PG8_WAIT_V(2); PG8_BAR;
        PG8_STAGE(PG8_SB(1, 0), cB + kstep, vBc); PG8_STAGE(PG8_SA(1, 0), cA + kstep, vAc); PG8_STAGE(PG8_SB(1, 1), cB + hB + kstep, vBc);
        PG8_WAIT_V(6); PG8_BAR; }
    for (;;) {
        const bool has_next = S.next(ui + 1, nxt);
        if (!has_next) nxt = cur;
        PG8_VOFF(vAn, vBn, nxt);
        const char* cA = cur.A; const char* cB = cur.B; const size_t hAc = (size_t)HALF * cur.lda2, hAn = (size_t)HALF * nxt.lda2, hBn = (size_t)HALF * nxt.ldb2, hBc = (size_t)HALF * cur.ldb2;
        const int nt = cur.nt;
        for (int t = 0; t < nt; t += 2) {
            const bool last = (t == nt - 2);
            const char* a1 = cA + (size_t)(t + 1) * kstep;
            const char* a2 = last ? nxt.A : cA + (size_t)(t + 2) * kstep; const char* b2 = last ? nxt.B : cB + (size_t)(t + 2) * kstep;
            const char* a3 = a2 + kstep; const char* b3 = b2 + kstep;
            unsigned vA2[2], vB2[2];
#pragma unroll
            for (int _i = 0; _i < 2; ++_i) { vA2[_i] = last ? vAn[_i] : vAc[_i]; vB2[_i] = last ? vBn[_i] : vBc[_i]; }
            const size_t hA2 = last ? hAn : hAc, hB2 = last ? hBn : hBc;
            PG8_LDB(B0, 0, 0); PG8_LDB(B1, 0, 1); PG8_SCHED; PG8_LDA(At, 0, 0); PG8_STAGE(PG8_SA(1, 1), a1 + hAc, vAc);
            PG8_WAIT_V(8); PG8_WAIT_L(0); PG8_BAR; PG8_MMA(0, 0, At, B0); PG8_MMA(0, 1, At, B1); PG8_BAR; PG8_SCHED;
            PG8_LDA(At, 0, 1); PG8_STAGE(PG8_SB(0, 0), b2, vB2); PG8_STAGE(PG8_SB(0, 1), b2 + hB2, vB2); PG8_STAGE(PG8_SA(0, 0), a2, vA2);
            PG8_WAIT_V(8); PG8_WAIT_L(0); PG8_BAR; PG8_MMA(1, 0, At, B0); PG8_MMA(1, 1, At, B1); PG8_BAR; PG8_SCHED;
            PG8_LDB(B0, 1, 0); PG8_LDB(B1, 1, 1); PG8_SCHED; PG8_LDA(At, 1, 0); PG8_STAGE(PG8_SA(0, 1), a2 + hA2, vA2);
            PG8_WAIT_V(8); PG8_WAIT_L(0); PG8_BAR; PG8_MMA(0, 0, At, B0); PG8_MMA(0, 1, At, B1); PG8_BAR; PG8_SCHED;
            PG8_LDA(At, 1, 1); PG8_STAGE(PG8_SB(1, 0), b3, vB2); PG8_STAGE(PG8_SB(1, 1), b3 + hB2, vB2); PG8_STAGE(PG8_SA(1, 0), a3, vA2);
            PG8_WAIT_V(8); PG8_WAIT_L(0); PG8_BAR; PG8_MMA(1, 0, At, B0); PG8_MMA(1, 1, At, B1); PG8_BAR; PG8_SCHED;
        }
        if constexpr (ALIGN_EPI) { if (wr == 0) PG8_BAR; }
        { Unit u{cur.pm, cur.pn};
          if (cur.mode == 1) { EpiBf<1> E{cur.O, cur.S1, cur.S2, ldc, nullptr, nullptr, nullptr, nullptr, nullptr}; E(acc, u, wr, wc, fr, fq); }
          else if (cur.mode == 2) { EpiBf<2> E{cur.O, cur.S1, cur.S2, ldc, nullptr, nullptr, nullptr, nullptr, nullptr}; E(acc, u, wr, wc, fr, fq); }
          else { EpiBf<3> E{cur.O, cur.S1, cur.S2, ldc, nullptr, nullptr, nullptr, nullptr, nullptr}; E(acc, u, wr, wc, fr, fq); } }
        if (!has_next) break;
#pragma unroll
        for (int a = 0; a < 2; ++a)
#pragma unroll
            for (int b = 0; b < 2; ++b)
#pragma unroll
                for (int m = 0; m < 4; ++m)
#pragma unroll
                    for (int n = 0; n < 2; ++n) acc[a][b][m][n] = (f32x4){0.f, 0.f, 0.f, 0.f};
        cur = nxt; ++ui;
#pragma unroll
        for (int _i = 0; _i < 2; ++_i) { vAc[_i] = vAn[_i]; vBc[_i] = vBn[_i]; }
        if constexpr (ALIGN_EPI) { if (wr == 1) PG8_BAR; }
    }
    PG8_WAIT_V(0);
    if constexpr (!ALIGN_EPI) { if (wr == 0) PG8_BAR; }
    PG8_BAR;
#undef PG8_SA
#undef PG8_SB
#undef PG8_STAGE
#undef PG8_LDA
#undef PG8_LDB
#undef PG8_MMA
#undef PG8_WAIT_V
#undef PG8_WAIT_L
#undef PG8_BAR
#undef PG8_SCHED
#undef PG8_VOFF
}
}
#define GAS __attribute__((address_space(1)))
#define LAS __attribute__((address_space(3)))
typedef unsigned short bf16;
typedef unsigned v4u __attribute__((ext_vector_type(4)));
typedef unsigned v2u __attribute__((ext_vector_type(2)));
typedef float f32x4 __attribute__((ext_vector_type(4)));
typedef short bf16x8 __attribute__((ext_vector_type(8)));
typedef GAS unsigned gu32;
typedef GAS unsigned long long gu64;
#define RLX_AGENT __ATOMIC_RELAXED, __HIP_MEMORY_SCOPE_AGENT
#define LDS_WAIT() asm volatile("s_waitcnt lgkmcnt(0)" ::: "memory")
#define VM_WAIT() asm volatile("s_waitcnt vmcnt(0)" ::: "memory")
__device__ __forceinline__ unsigned long long rt() { return __builtin_amdgcn_s_memrealtime(); }
__device__ __forceinline__ unsigned f2bf(float f) { unsigned u = __builtin_bit_cast(unsigned, f); return (u + 0x7fffu + ((u >> 16) & 1u)) >> 16; }
typedef float f32x2_t __attribute__((ext_vector_type(2))); typedef __bf16 bf16x2_t __attribute__((ext_vector_type(2)));
__device__ __forceinline__ unsigned pk2(float lo, float hi) { const f32x2_t v = {lo, hi}; const bf16x2_t b = __builtin_convertvector(v, bf16x2_t); return __builtin_bit_cast(unsigned, b); }

#define XB_TMO      128
#define XB_XCNT(j)  (256  + 64 * (j))
#define XB_XSUB(j)  (1280 + 64 * (j))
#define XB_XGEN(j)  (2304 + 64 * (j))
#define XB_TOP      3328
#define XB_TOPGEN   3392
#define XCD_BAR_WORDS 3456
#define XB_SPIN_CAP (1u << 22)

__device__ __forceinline__ unsigned xb_ld(unsigned* p)              { return __hip_atomic_load(p, __ATOMIC_RELAXED, __HIP_MEMORY_SCOPE_AGENT); }
__device__ __forceinline__ unsigned xb_add(unsigned* p, unsigned v) { return __hip_atomic_fetch_add(p, v, __ATOMIC_RELAXED, __HIP_MEMORY_SCOPE_AGENT); }
__device__ __forceinline__ unsigned xb_xcc_id() { return (unsigned)__builtin_amdgcn_s_getreg((3 << 11) | 20) & 0xFu; }
#define XB_SPIN(cond, bar) do { unsigned _sp = 0; while (cond) { __builtin_amdgcn_s_sleep(1); \
    if ((++_sp & 255u) == 0u) { if (xb_ld(&(bar)[XB_TMO])) break; if (_sp > XB_SPIN_CAP) { atomicAdd(&(bar)[XB_TMO], 1u); break; } } } } while (0)

struct XcdBarrier {
    unsigned* bar; unsigned x;
    volatile LAS unsigned* st;
};

__device__ __forceinline__ XcdBarrier xcd_barrier_post(unsigned* bar, volatile LAS unsigned* st) {
    XcdBarrier b; b.bar = bar; b.x = xb_xcc_id(); b.st = st;
    if (threadIdx.x == 0) (void)xb_add(&bar[XB_XCNT(b.x)], 1u);
    return b;
}
__device__ __forceinline__ void xcd_barrier_complete(unsigned* bar, unsigned x, unsigned& nloc, unsigned& nx) {
    const unsigned G = gridDim.x * gridDim.y * gridDim.z;
    unsigned sum, cnt, mine, sp = 0u;
    for (;;) {
        sum = 0u; cnt = 0u; mine = 0u;
#pragma unroll
        for (unsigned j = 0; j < 16; ++j) { const unsigned c = xb_ld(&bar[XB_XCNT(j)]); sum += c; cnt += (c > 0u) ? 1u : 0u; mine = (j == x) ? c : mine; }
        if (sum == G) break;
        __builtin_amdgcn_s_sleep(1);
        if ((++sp & 255u) == 0u) { if (xb_ld(&bar[XB_TMO])) break; if (sp > XB_SPIN_CAP) { atomicAdd(&bar[XB_TMO], 1u); break; } }
    }
    nloc = mine > 0u ? mine : 1u; nx = cnt > 0u ? cnt : 1u;
}

__device__ __forceinline__ void xcd_barrier(const XcdBarrier& b) {
    asm volatile("s_waitcnt vmcnt(0)" ::: "memory");
    __syncthreads();
    if (threadIdx.x == 0) {
        unsigned* bar = b.bar;
        __builtin_amdgcn_s_waitcnt(0);
        unsigned nloc = b.st[0], nx = b.st[1];
        if (nloc == 0u) { xcd_barrier_complete(bar, b.x, nloc, nx); b.st[0] = nloc; b.st[1] = nx; }
        const unsigned old = xb_add(&bar[XB_XSUB(b.x)], 1u);
        const unsigned gen = old / nloc;
        if (old + 1u == (gen + 1u) * nloc) {
            __builtin_amdgcn_fence(__ATOMIC_RELEASE, "agent");
            asm volatile("s_waitcnt vmcnt(0)" ::: "memory");
            const unsigned og = xb_add(&bar[XB_TOP], 1u);
            const unsigned tg = og / nx;
            if (og + 1u == (tg + 1u) * nx) xb_add(&bar[XB_TOPGEN], 1u);
            else XB_SPIN(xb_ld(&bar[XB_TOPGEN]) == tg, bar);
            __builtin_amdgcn_fence(__ATOMIC_ACQUIRE, "agent");
            xb_add(&bar[XB_XGEN(b.x)], 1u);
            asm volatile("s_waitcnt vmcnt(0)" ::: "memory");
        } else {
            XB_SPIN(xb_ld(&bar[XB_XGEN(b.x)]) == gen, bar);
            __builtin_amdgcn_fence(__ATOMIC_ACQUIRE, "agent");
            asm volatile("s_waitcnt vmcnt(0)" ::: "memory");
        }
    }
    __syncthreads();
}

constexpr int NWAVES = 8;
constexpr int BATCH = 8, T = 2048, D = 1024, M = BATCH * T;
constexpr int IN_COLS = 9224;
constexpr int NPROJ = 7168;
constexpr int C_DNQ = 0, C_DNK = 512, C_DNV = 1024, C_DNZ = 1536, C_SQ = 2048, C_SK = 3584, C_SV = 5120, C_SZ = 6656;
constexpr float EPS = 1e-6f;
constexpr float QK_SCALE = 0.08838834764831845f;

constexpr size_t MiB = 1u << 20;
constexpr size_t WS_CTL = 0, CTL_ZERO_BYTES = 32768;
constexpr size_t WS_BG = 1 * MiB;
constexpr size_t WS_ROPE = 1 * MiB + 512 * 1024;
constexpr size_t WS_WG = 2 * MiB;
constexpr size_t WS_WDN = 6 * MiB, WS_WSWA = 7 * MiB;
constexpr size_t WS_WOUT = 8 * MiB;
constexpr size_t WS_WIN = 10 * MiB;
constexpr size_t WS_PROJ = 32 * MiB;
constexpr size_t WS_END = 256 * MiB;
static_assert(WS_WIN + (size_t)NPROJ * D * 2 <= WS_PROJ && WS_PROJ + (size_t)M * NPROJ * 2 <= WS_END, "d_ws map");
constexpr size_t OUT_LT = 32 * MiB, OUT_A = 48 * MiB, OUT_HALO = 58 * MiB, OUT_CS = 61 * MiB;
constexpr size_t WS_LSE = 24 * MiB;
constexpr size_t OUT_ODN = 32 * MiB, OUT_OSWA = 48 * MiB;
constexpr size_t PJ_SCR1 = 0, PJ_SCR2 = 32 * MiB, PJ_SCR3 = 64 * MiB, PJ_MERGED = 96 * MiB;
constexpr int CW_BAR = 4096;

constexpr int RING_OFF = 0, RING_BYTES = 147456;
constexpr int LDSCTL_OFF = RING_BYTES, MISC_OFF = LDSCTL_OFF + 320;
constexpr int LDS_BYTES = 163840;


struct Frame {
    LAS unsigned char* lds;
    volatile LAS unsigned* MISC;
    gu32* ctl;
    int tid, lane, wave;
    int vcu, G;
    const float *x, *norm_w, *w_in, *conv_w, *a_log, *dt_bias, *dn_norm_w, *q_norm_w, *k_norm_w, *w_bdn, *w_bswa, *w_out;
    float* out;
    bf16 *WinT, *WgT, *WdnT, *WswaT, *WoutT, *H, *PROJ;
    float* BG; float* ROPE; float* LSE; float* LT; float* CS; bf16* AIMG; bf16* HALO; bf16* ODN; bf16* OSWA;
};
template <int N> __device__ __forceinline__ float row_ror(float v) { return __builtin_bit_cast(float, __builtin_amdgcn_update_dpp(0, __builtin_bit_cast(int, v), 0x120 + N, 0xf, 0xf, true)); }
__device__ __forceinline__ float row16_sum(float v) { v += row_ror<8>(v); v += row_ror<4>(v); v += row_ror<2>(v); v += row_ror<1>(v); return v; }
__device__ __forceinline__ float wave_sum(float v) {
    v = row16_sum(v);
    { const auto t = __builtin_amdgcn_permlane16_swap(__float_as_uint(v), __float_as_uint(v), false, false); v = __uint_as_float(t[0]) + __uint_as_float(t[1]); }
    { const auto t = __builtin_amdgcn_permlane32_swap(__float_as_uint(v), __float_as_uint(v), false, false); v = __uint_as_float(t[0]) + __uint_as_float(t[1]); }
    return v;
}
__device__ __forceinline__ float bf_lo(unsigned w) { return __builtin_bit_cast(float, w << 16); }
__device__ __forceinline__ float bf_hi(unsigned w) { return __builtin_bit_cast(float, w & 0xffff0000u); }
__device__ __forceinline__ float bf2f(bf16 v) { return __builtin_bit_cast(float, (unsigned)v << 16); }
__device__ __forceinline__ float siluf_(float a) { return a * __builtin_amdgcn_rcpf(1.0f + __expf(-a)); }
__device__ __forceinline__ float sigm_(float a) { return __builtin_amdgcn_rcpf(1.0f + __expf(-a)); }

struct TrItem { const float* src; bf16* dst; int ldw, K, k0, perm; };
__device__ __forceinline__ void tr_load(const TrItem& t, float (&tv)[32], int lane) {
#pragma unroll
    for (int i = 0; i < 32; ++i) { const int kk = 2 * i + (lane >> 5); tv[i] = t.src[(size_t)(t.k0 + kk) * t.ldw + (lane & 31)]; }
}
__device__ __forceinline__ void tr_scatter(const float (&tv)[32], LAS float* scr, int lane) {
#pragma unroll
    for (int i = 0; i < 32; ++i) { const int kk = 2 * i + (lane >> 5); scr[kk * 33 + (lane & 31)] = tv[i]; }
    LDS_WAIT(); asm volatile("" ::: "memory");
}
__device__ __forceinline__ void tr_store(const TrItem& t, LAS float* scr, int lane) {
    const int c = lane & 7;
#pragma unroll
    for (int j = 0; j < 4; ++j) { const int n = (lane >> 3) + 8 * j, np = t.perm ? (n < 16 ? 2 * n : 2 * (n - 16) + 1) : n; const LAS float* s = scr + (8 * c) * 33 + n;
        v4u o; o.x = pk2(s[0 * 33], s[1 * 33]); o.y = pk2(s[2 * 33], s[3 * 33]); o.z = pk2(s[4 * 33], s[5 * 33]); o.w = pk2(s[6 * 33], s[7 * 33]);
        *(GAS v4u*)(t.dst + (size_t)np * t.K + t.k0 + 8 * c) = o; }
    LDS_WAIT(); asm volatile("" ::: "memory");
}
constexpr int TR_I_IN = 16 * (NPROJ / 32), TR_I_G = 16 * 64, TR_I_DN = 8 * 32, TR_I_SWA = 8 * 32, TR_I_OUT = 16 * 32, TR_NITEMS = TR_I_IN + TR_I_G + TR_I_DN + TR_I_SWA + TR_I_OUT;
__device__ __forceinline__ TrItem tr_decode(Frame& F, int it) {
    TrItem t; int r = it; t.perm = 0;
    if (r < TR_I_IN) { const int kb = r / (NPROJ / 32), nb = r % (NPROJ / 32), n0 = nb * 32, sc = n0 < 2048 ? n0 : n0 + 8; t.perm = (n0 >= C_SQ && n0 < C_SV && ((n0 - C_SQ) & 127) == 0) ? 1 : 0; t.src = F.w_in + sc; t.ldw = IN_COLS; t.dst = F.WinT + (size_t)n0 * D; t.K = D; t.k0 = kb * 64; return t; } r -= TR_I_IN;
    if (r < TR_I_G) { const int kb = r / 64, nb = r % 64, n0 = nb * 32; t.src = F.w_in + 7176 + n0; t.ldw = IN_COLS; t.dst = F.WgT + (size_t)n0 * D; t.K = D; t.k0 = kb * 64; return t; } r -= TR_I_G;
    if (r < TR_I_DN) { const int kb = r / 32, nb = r % 32, n0 = nb * 32; t.src = F.w_bdn + n0; t.ldw = D; t.dst = F.WdnT + (size_t)n0 * 512; t.K = 512; t.k0 = kb * 64; return t; } r -= TR_I_DN;
    if (r < TR_I_SWA) { const int kb = r / 32, nb = r % 32, n0 = nb * 32; t.src = F.w_bswa + n0; t.ldw = D; t.dst = F.WswaT + (size_t)n0 * 512; t.K = 512; t.k0 = kb * 64; return t; } r -= TR_I_SWA;
    { const int kb = r / 32, nb = r % 32, n0 = nb * 32; t.src = F.w_out + n0; t.ldw = D; t.dst = F.WoutT + (size_t)n0 * D; t.K = D; t.k0 = kb * 64; return t; }
}
__device__ __forceinline__ void tr_run(Frame& F, int lo, int hi, LAS float* scr, int gw, int NGW) {
    const int lane = F.lane;
    if (lo + gw < hi) {
        float tv[32]; TrItem cur = tr_decode(F, lo + gw); tr_load(cur, tv, lane);
        for (int it = lo + gw; it < hi; it += NGW) {
            tr_scatter(tv, scr, lane);
            TrItem nxt = cur; const bool more = it + NGW < hi;
            if (more) { nxt = tr_decode(F, it + NGW); tr_load(nxt, tv, lane); }
            tr_store(cur, scr, lane);
            cur = nxt;
        }
    }
}
__device__ __forceinline__ void p0_prologue(Frame& F) {
    LAS float* scr = (LAS float*)(F.lds + RING_OFF + F.wave * 8704);
    const int gw = F.vcu * NWAVES + F.wave, NGW = F.G * NWAVES, lane = F.lane;
    LAS float* wsm = (LAS float*)(F.lds + RING_OFF + 8 * 8704);
    for (int idx = F.tid; idx < 1024 * 8; idx += NWAVES * 64) { const int k = idx >> 3, j = idx & 7; const float v = F.w_in[(size_t)k * IN_COLS + 2048 + j];
        const int ln = (k & 255) >> 2, e = k & 3, jj = k >> 8, c = jj * 4 + e, half = j >> 2; wsm[((half * 16 + c) * 64 + ln) * 4 + (j & 3)] = v; }
    __syncthreads();
    static_assert(TR_I_IN <= 2 * 256 * NWAVES && TR_I_IN > 256 * NWAVES, "one or two in-projection transpose items per wave");
    tr_run(F, NGW, TR_I_IN, scr, gw, NGW);
    float tvA[32]; const TrItem tiA = tr_decode(F, gw); tr_load(tiA, tvA, lane);
    {
        static constexpr double INVF[16] = {1.0, 0.44036660267178046, 0.19392274474868576, 0.08539710028576561, 0.03760603093086393, 0.016560440080994446, 0.007292664737217109, 0.003211445994752591,
                                            0.001414213562373095, 0.000622772421914596, 0.0002742481756762073, 0.00012076973741146504, 5.318295896944988e-05, 2.341999896140934e-05, 1.031338537721246e-05, 4.5416704806078695e-06};
        for (int gt = F.vcu * (NWAVES * 64) + F.tid; gt < T * 16; gt += F.G * NWAVES * 64) {
            const int pos = gt >> 4, i = gt & 15;
            double a = (double)pos * INVF[i] * 0.15915494309189535;
            a -= __builtin_rint(a);
            const float af = (float)a;
            F.ROPE[gt * 2] = __builtin_amdgcn_cosf(af); F.ROPE[gt * 2 + 1] = __builtin_amdgcn_sinf(af);
        }
    }
    f32x4 xn[4];
    { const GAS f32x4* xr = (const GAS f32x4*)(F.x + (size_t)gw * D) + lane;
#pragma unroll
      for (int j = 0; j < 4; ++j) xn[j] = xr[64 * j]; }
    for (int m = gw; m < M; m += NGW) {
        f32x4 v[4]; float ss = 0.f;
#pragma unroll
        for (int j = 0; j < 4; ++j) { v[j] = xn[j]; ss += (v[j].x * v[j].x + v[j].y * v[j].y) + (v[j].z * v[j].z + v[j].w * v[j].w); }
        if (m + NGW < M) { const GAS f32x4* xr = (const GAS f32x4*)(F.x + (size_t)(m + NGW) * D) + lane;
#pragma unroll
            for (int j = 0; j < 4; ++j) xn[j] = xr[64 * j]; }
        const float rstd = __builtin_amdgcn_rsqf(wave_sum(ss) * (1.f / D) + EPS);
#pragma unroll
        for (int j = 0; j < 4; ++j) { const f32x4 nw = ((const GAS f32x4*)F.norm_w)[lane + 64 * j]; v[j] = (v[j] * rstd) * nw; }
        GAS unsigned long long* o8 = (GAS unsigned long long*)(F.H + (size_t)m * D) + lane;
#pragma unroll
        for (int j = 0; j < 4; ++j) o8[64 * j] = (unsigned long long)pk2(v[j].x, v[j].y) | ((unsigned long long)pk2(v[j].z, v[j].w) << 32);
        f32x4 plo = {0.f, 0.f, 0.f, 0.f}, phi = {0.f, 0.f, 0.f, 0.f};
#pragma unroll
        for (int jj = 0; jj < 4; ++jj)
#pragma unroll
            for (int e = 0; e < 4; ++e) { const int c = jj * 4 + e; const float hv = v[jj][e];
                const f32x4 wlo = *(const LAS f32x4*)(wsm + ((0 * 16 + c) * 64 + lane) * 4), whi = *(const LAS f32x4*)(wsm + ((1 * 16 + c) * 64 + lane) * 4);
                plo += wlo * hv; phi += whi * hv; }
        float r4[4];
        { const float lo4[4] = {plo.x, plo.y, plo.z, plo.w}, hi4[4] = {phi.x, phi.y, phi.z, phi.w};
#pragma unroll
          for (int j = 0; j < 4; ++j) { const auto t = __builtin_amdgcn_permlane32_swap(__float_as_uint(lo4[j]), __float_as_uint(hi4[j]), false, false); r4[j] = __uint_as_float(t[0]) + __uint_as_float(t[1]); } }
        float u0, u1;
        { const auto t = __builtin_amdgcn_permlane16_swap(__float_as_uint(r4[0]), __float_as_uint(r4[2]), false, false); u0 = __uint_as_float(t[0]) + __uint_as_float(t[1]); }
        { const auto t = __builtin_amdgcn_permlane16_swap(__float_as_uint(r4[1]), __float_as_uint(r4[3]), false, false); u1 = __uint_as_float(t[0]) + __uint_as_float(t[1]); }
        u0 = row16_sum(u0); u1 = row16_sum(u1);
        if ((lane & 15) < 2) { const int j = 2 * (lane >> 4) + (lane & 1), h = j & 3; const float val = (lane & 1) ? u1 : u0; float o;
            if (j < 4) o = sigm_(val);
            else { const float xx = val + F.dt_bias[h];
                const float sp = xx > 20.f ? xx : 0.6931471805599453f * __builtin_amdgcn_logf(1.0f + __expf(xx)); o = -__expf(F.a_log[h]) * sp; }
            F.BG[(size_t)m * 8 + j] = o; }
    }
    tr_scatter(tvA, scr, lane); tr_store(tiA, scr, lane);
}

constexpr float SC2 = QK_SCALE * 1.4426950408889634f;
typedef short v4i16_t __attribute__((ext_vector_type(4)));
__device__ __forceinline__ int offK(int row, int b) { return row * 256 + (b ^ ((row & 15) << 4)); }
__device__ __forceinline__ int offV(int row, int b) { return row * 256 + (b ^ ((row & 7) << 5)); }
__device__ __forceinline__ v4i16_t vtr(const LAS unsigned char* p) { return __builtin_amdgcn_ds_read_tr16_b64_v4i16((LAS v4i16_t*)p); }
struct AttnItem { int b, g, h, r, n, sh; };
__device__ __forceinline__ float xrow_max(float v) {
    { const auto t = __builtin_amdgcn_permlane16_swap(__float_as_uint(v), __float_as_uint(v), false, false); v = fmaxf(__uint_as_float(t[0]), __uint_as_float(t[1])); }
    { const auto t = __builtin_amdgcn_permlane32_swap(__float_as_uint(v), __float_as_uint(v), false, false); v = fmaxf(__uint_as_float(t[0]), __uint_as_float(t[1])); }
    return v; }
__device__ __forceinline__ float xrow_sum(float v) {
    { const auto t = __builtin_amdgcn_permlane16_swap(__float_as_uint(v), __float_as_uint(v), false, false); v = __uint_as_float(t[0]) + __uint_as_float(t[1]); }
    { const auto t = __builtin_amdgcn_permlane32_swap(__float_as_uint(v), __float_as_uint(v), false, false); v = __uint_as_float(t[0]) + __uint_as_float(t[1]); }
    return v; }
__device__ __forceinline__ void attn_stage_half(Frame& F, const AttnItem& a, int hlog, int slot, LAS unsigned char* ldsK, LAS unsigned char* ldsV) {
    const int lane = F.lane, w = F.wave; const size_t rowb = (size_t)a.b * T;
#pragma unroll
    for (int i = 0; i < 4; ++i) { const int p = 4 * w + i, jl = 4 * p + (lane >> 4), s = 128 * (a.n - 1 + hlog) + jl; const int pos = (s << a.sh) + a.r;
        const bf16* rp = F.PROJ + (rowb + pos) * NPROJ + a.g * 512 + a.h * 128; const int pc = lane & 15;
        __builtin_amdgcn_global_load_lds((const unsigned*)(rp + C_SK + ((pc ^ (jl & 15)) * 8)), (LAS unsigned*)(ldsK + slot * 32768 + p * 1024), 16, 0, 0);
        __builtin_amdgcn_global_load_lds((const unsigned*)(rp + C_SV + ((pc ^ ((jl & 7) << 1)) * 8)), (LAS unsigned*)(ldsV + slot * 32768 + p * 1024), 16, 0, 0); }
}
__device__ __forceinline__ void p2_attn_run(Frame& F, int q) {
    const int lane = F.lane, w = F.wave, l15 = lane & 15, g4 = lane >> 4;
    LAS unsigned char* ldsK = F.lds + RING_OFF; LAS unsigned char* ldsV = F.lds + RING_OFF + 65536;
    const int bgh = q >> 1, hf = q & 1;
    AttnItem a; a.g = bgh % 3; { const int bh = bgh / 3; a.h = bh & 3; a.b = bh >> 2; } a.sh = 2 * a.g;
    int par = 0; bool staged = false;
    v4u qn[4];
    { AttnItem a0 = a; const int x0 = hf * 8; a0.r = x0 >> (4 - a.sh); a0.n = x0 & ((16 >> a.sh) - 1);
      const int posq0 = ((128 * a0.n + 16 * w + l15) << a.sh) + a0.r; const bf16* q0 = F.PROJ + ((size_t)a.b * T + posq0) * NPROJ + C_SQ + a.g * 512 + a.h * 128;
#pragma unroll
      for (int kk = 0; kk < 4; ++kk) qn[kk] = *(const GAS v4u*)(q0 + 32 * kk + 8 * g4); }
    for (int k = 0; k < 8; ++k) {
    const int x = hf * 8 + k; a.r = x >> (4 - a.sh); a.n = x & ((16 >> a.sh) - 1);
    const int g = a.g, h = a.h, r = a.r, n = a.n, sh = a.sh;
    const size_t rowb = (size_t)a.b * T;
    if (!staged) { par = 0; if (n > 0) attn_stage_half(F, a, 0, 0, ldsK, ldsV); attn_stage_half(F, a, 1, 1, ldsK, ldsV); }
    AttnItem an = a; bool nxt_one = false;
    if (k < 7) { const int xn = x + 1; an.r = xn >> (4 - a.sh); an.n = xn & ((16 >> a.sh) - 1); nxt_one = (an.n == 0) || (an.r == a.r && an.n == a.n + 1); }
    const int qi = 16 * w + l15, sq = 128 * n + qi, posq = (sq << sh) + r;
    bf16* qrow = F.PROJ + (rowb + posq) * NPROJ + C_SQ + g * 512 + h * 128;
    asm volatile("s_waitcnt vmcnt(0)" ::: "memory");
    __syncthreads();
    pg8::bf16x8 qf[4];
#pragma unroll
    for (int kk = 0; kk < 4; ++kk) qf[kk] = __builtin_bit_cast(pg8::bf16x8, qn[kk]);
    if (k < 7) { const int posqn = ((128 * an.n + qi) << sh) + an.r; const bf16* qr2 = F.PROJ + (rowb + posqn) * NPROJ + C_SQ + g * 512 + h * 128;
#pragma unroll
        for (int kk = 0; kk < 4; ++kk) qn[kk] = *(const GAS v4u*)(qr2 + 32 * kk + 8 * g4); }
    float m = -1e30f, lsum = 0.f;
    f32x4 O[8];
#pragma unroll
    for (int dt = 0; dt < 8; ++dt) O[dt] = (f32x4){0.f, 0.f, 0.f, 0.f};
    const int jb0 = 32 * (w >> 1);
    const int trq = l15 >> 2, trp = l15 & 3;
#pragma unroll
    for (int c = 0; c < 5; ++c) {
        const int jb = jb0 + 32 * c;
        if (c == 4) {
            asm volatile("s_waitcnt lgkmcnt(0)" ::: "memory"); __builtin_amdgcn_s_barrier(); asm volatile("" ::: "memory");
            if (nxt_one) attn_stage_half(F, an, 1, par, ldsK, ldsV);
        }
        if (n == 0 && jb + 31 < 128) continue;
        const int jp = (((jb >> 7) ^ par) << 7) + (jb & 127);
        f32x4 s0 = {0.f, 0.f, 0.f, 0.f}, s1 = {0.f, 0.f, 0.f, 0.f};
        {   pg8::bf16x8 ka[4], kb[4];
#pragma unroll
            for (int kk = 0; kk < 4; ++kk) { ka[kk] = *(const LAS pg8::bf16x8*)(ldsK + offK(jp + l15, 64 * kk + 16 * g4)); kb[kk] = *(const LAS pg8::bf16x8*)(ldsK + offK(jp + 16 + l15, 64 * kk + 16 * g4)); }
            __builtin_amdgcn_sched_barrier(0);
#pragma unroll
            for (int kk = 0; kk < 4; ++kk) { s0 = __builtin_amdgcn_mfma_f32_16x16x32_bf16(ka[kk], qf[kk], s0, 0, 0, 0); s1 = __builtin_amdgcn_mfma_f32_16x16x32_bf16(kb[kk], qf[kk], s1, 0, 0, 0); } }
        float xs[8]; float tmax = -INFINITY;
        if (c == 0 || c == 4) {
#pragma unroll
            for (int e = 0; e < 4; ++e) {
                const int j0 = jb + 4 * g4 + e, j1 = j0 + 16; const int d0 = j0 - qi, d1 = j1 - qi;
                const bool ok0 = (c == 0) ? (d0 >= 0) : (d0 <= 128), ok1 = (c == 0) ? (d1 >= 0) : (d1 <= 128);
                xs[e] = ok0 ? s0[e] : -INFINITY; xs[4 + e] = ok1 ? s1[e] : -INFINITY;
                tmax = fmaxf(tmax, fmaxf(xs[e], xs[4 + e])); }
        } else {
#pragma unroll
            for (int e = 0; e < 4; ++e) { xs[e] = s0[e]; xs[4 + e] = s1[e]; tmax = fmaxf(tmax, fmaxf(xs[e], xs[4 + e])); }
        }
        tmax = xrow_max(tmax);
        const float mn = fmaxf(m, tmax * SC2), alpha = __builtin_amdgcn_exp2f(m - mn);
        float ps = 0.f;
#pragma unroll
        for (int e = 0; e < 8; ++e) { xs[e] = __builtin_amdgcn_exp2f(__builtin_fmaf(xs[e], SC2, -mn)); ps += xs[e]; }
        lsum = lsum * alpha + ps;
        if (__builtin_amdgcn_ballot_w64(mn > m) != 0ull) {
#pragma unroll
            for (int dt = 0; dt < 8; ++dt) O[dt] = O[dt] * alpha; }
        m = mn;
        v4u pw; pw.x = pk2(xs[0], xs[1]); pw.y = pk2(xs[2], xs[3]); pw.z = pk2(xs[4], xs[5]); pw.w = pk2(xs[6], xs[7]);
        const pg8::bf16x8 pf = __builtin_bit_cast(pg8::bf16x8, pw);
        const int vr1 = jp + 4 * g4 + trq, vr2 = vr1 + 16;
        v4i16_t tv1[8], tv2[8];
#pragma unroll
        for (int dt = 0; dt < 8; ++dt) { tv1[dt] = vtr(ldsV + offV(vr1, 32 * dt + 8 * trp)); tv2[dt] = vtr(ldsV + offV(vr2, 32 * dt + 8 * trp)); }
#pragma unroll
        for (int dt = 0; dt < 8; ++dt) {
            const pg8::bf16x8 af = {tv1[dt][0], tv1[dt][1], tv1[dt][2], tv1[dt][3], tv2[dt][0], tv2[dt][1], tv2[dt][2], tv2[dt][3]};
            O[dt] = __builtin_amdgcn_mfma_f32_16x16x32_bf16(af, pf, O[dt], 0, 0, 0);
        }
    }
    const float lt = xrow_sum(lsum);
    const float inv = __builtin_amdgcn_rcpf(lt);
    {   LAS unsigned char* Ow = F.lds + 131072 + w * 2048;
        const int rr_ = lane >> 3, cc_ = lane & 7;
        bf16* qr0 = F.PROJ + (rowb + (((128 * n + 16 * w + rr_) << sh) + r)) * NPROJ + C_SQ + g * 512 + h * 128 + cc_ * 8;
        bf16* qr1 = F.PROJ + (rowb + (((128 * n + 16 * w + rr_ + 8) << sh) + r)) * NPROJ + C_SQ + g * 512 + h * 128 + cc_ * 8;
#pragma unroll
        for (int p = 0; p < 2; ++p) {
#pragma unroll
            for (int d4 = 0; d4 < 4; ++d4) { const f32x4 o = O[4 * p + d4] * inv;
                const v2u pk = {pk2(o[0], o[1]), pk2(o[2], o[3])};
                *(LAS v2u*)(Ow + l15 * 128 + (((2 * d4 + (g4 >> 1)) ^ (l15 & 7)) << 4) + 8 * (g4 & 1)) = pk; }
            asm volatile("s_waitcnt lgkmcnt(0)" ::: "memory");
            const v4u a0 = *(const LAS v4u*)(Ow + rr_ * 128 + ((cc_ ^ (rr_ & 7)) << 4)), a1 = *(const LAS v4u*)(Ow + (rr_ + 8) * 128 + ((cc_ ^ (rr_ & 7)) << 4));
            asm volatile("s_waitcnt lgkmcnt(0)" ::: "memory");
            *(GAS v4u*)(qr0 + 64 * p) = a0; *(GAS v4u*)(qr1 + 64 * p) = a1;
        }
    }
    if (g4 == 0) F.LSE[((rowb + posq) * 3 + g) * 4 + h] = m + __builtin_amdgcn_logf(lt);
    if (nxt_one) { staged = true; par ^= 1; }
    else { staged = false; asm volatile("s_waitcnt lgkmcnt(0)" ::: "memory"); __builtin_amdgcn_s_barrier(); asm volatile("" ::: "memory"); }
    }
}
#define PREP_MAP() const int gi_ = (tid - 256) >> 4, unit_ = F.wave < 4 ? tid : (16 + (gi_ >> 1)) * 16 + (tid & 15), nr = F.wave < 4 ? 8 : 4; \
    const int rg = unit_ / 48, rem = unit_ - rg * 48, which = rem >> 4, ch = rem & 15, col = which * 512 + h * 128 + ch * 8, rbase = rg * 8 + (F.wave < 4 ? 0 : 4 * (gi_ & 1))
__device__ __forceinline__ void prepA_load(Frame& F, int item, v4u (&raw)[11], f32x4 (&cw)[4][2], float& gv, float& bt) {
    const int tid = F.tid; const int h = item & 3, cg = item >> 2, n = cg & 31; const size_t row0 = (size_t)cg * 64;
    PREP_MAP();
    if (F.wave == 7) { gv = F.BG[(row0 + F.lane) * 8 + 4 + h]; bt = F.BG[(row0 + F.lane) * 8 + h]; }
    {
#pragma unroll
        for (int j = 0; j < 4; ++j) { cw[j][0] = *(const GAS f32x4*)(F.conv_w + j * 1536 + col); cw[j][1] = *(const GAS f32x4*)(F.conv_w + j * 1536 + col + 4); }
#pragma unroll
        for (int i = 0; i < 11; ++i) if (i < nr + 3) { const int rr = rbase - 3 + i;
            if (rr >= 0) raw[i] = *(const GAS v4u*)(F.PROJ + (row0 + rr) * NPROJ + col);
            else if (n > 0) raw[i] = *(const GAS v4u*)(F.HALO + ((size_t)(cg - 1) * 3 + (rr + 3)) * 1536 + col);
            else raw[i] = (v4u){0u, 0u, 0u, 0u}; }
    }
}
__device__ __forceinline__ void prepA_conv(Frame& F, int item, const v4u (&raw)[11], const f32x4 (&cw)[4][2], float gv, float bt, int buf) {
    const int tid = F.tid, lane = F.lane, w = F.wave; const int h = item & 3, cg = item >> 2; const size_t row0 = (size_t)cg * 64;
    LAS unsigned char* Qi = F.lds + RING_OFF + buf * 33792; LAS unsigned char* Ki = Qi + 16384; LAS float* gcs = (LAS float*)(Ki + 16384); LAS float* bts = gcs + 64;
    PREP_MAP();
    if (w == 7) {
        float x = gv;
#define DPP_ADD(ctrl, rmask) x += __builtin_bit_cast(float, __builtin_amdgcn_update_dpp(0, __builtin_bit_cast(int, x), ctrl, rmask, 0xf, false))
        DPP_ADD(0x111, 0xf); DPP_ADD(0x112, 0xf); DPP_ADD(0x114, 0xf); DPP_ADD(0x118, 0xf); DPP_ADD(0x142, 0xa); DPP_ADD(0x143, 0xc);
#undef DPP_ADD
        const float glast = __builtin_bit_cast(float, __builtin_amdgcn_readlane(__builtin_bit_cast(int, x), 63));
        gcs[lane] = x; bts[lane] = bt;
        float* cs = F.CS + (size_t)item * 256; cs[lane] = __expf(x); cs[64 + lane] = bt; cs[128 + lane] = __expf(glast - x); if (lane == 0) cs[192] = __expf(glast);
    }
    {
#pragma unroll
        for (int r = 0; r < 8; ++r) if (r < nr) {
            f32x2_t y[4];
#pragma unroll
            for (int e = 0; e < 4; ++e) y[e] = (f32x2_t){0.f, 0.f};
#pragma unroll
            for (int j = 0; j < 4; ++j) { const v4u rv = raw[r + j]; const unsigned rw[4] = {rv.x, rv.y, rv.z, rv.w};
#pragma unroll
                for (int e = 0; e < 4; ++e) { const f32x2_t xv = {bf_lo(rw[e]), bf_hi(rw[e])}; const f32x2_t wv = {cw[j][e >> 1][2 * (e & 1)], cw[j][e >> 1][2 * (e & 1) + 1]}; y[e] += wv * xv; } }
            f32x2_t s2 = {0.f, 0.f};
#pragma unroll
            for (int e = 0; e < 4; ++e) { const f32x2_t t = y[e] * -1.4426950408889634f; f32x2_t ex = {__builtin_amdgcn_exp2f(t.x), __builtin_amdgcn_exp2f(t.y)}; ex = ex + 1.0f;
                const f32x2_t rc = {__builtin_amdgcn_rcpf(ex.x), __builtin_amdgcn_rcpf(ex.y)}; y[e] = y[e] * rc; s2 += y[e] * y[e]; }
            const float ss = row16_sum(s2.x + s2.y);
            const float scl = which == 2 ? 1.f : __builtin_amdgcn_rsqf(ss + EPS) * (which == 0 ? QK_SCALE : 1.f);
            v4u o; o.x = pk2(y[0].x * scl, y[0].y * scl); o.y = pk2(y[1].x * scl, y[1].y * scl); o.z = pk2(y[2].x * scl, y[2].y * scl); o.w = pk2(y[3].x * scl, y[3].y * scl);
            const int rr = rbase + r;
            *(GAS v4u*)(F.PROJ + (row0 + rr) * NPROJ + col) = o;
            if (which < 2) *(LAS v4u*)((which == 0 ? Qi : Ki) + offK(rr, ch * 16)) = o;
        }
    }
}
__device__ __forceinline__ void prepA_mfma(Frame& F, int item, int buf) {
    const int lane = F.lane, w = F.wave, l15 = lane & 15, g4 = lane >> 4;
    LAS unsigned char* Qi = F.lds + RING_OFF + buf * 33792; LAS unsigned char* Ki = Qi + 16384; LAS float* gcs = (LAS float*)(Ki + 16384); LAS float* bts = gcs + 64;
    const int whichm = w >> 2, wi = w & 3; const LAS unsigned char* Xi = whichm ? Qi : Ki;
    float* Lg = F.LT + (size_t)item * 4096; bf16* Ag = F.AIMG + (size_t)item * 4096;
#define BLK(mt, nt, v) ((mt) | ((nt) << 2) | ((v) << 4))
    const unsigned listL = wi == 0 ? (BLK(3, 3, 1) | BLK(0, 0, 1) << 8 | BLK(1, 0, 1) << 16) : wi == 1 ? (BLK(3, 2, 1) | BLK(1, 1, 1) << 8 | BLK(2, 0, 1) << 16) : wi == 2 ? (BLK(3, 1, 1) | BLK(2, 2, 1) << 8) : (BLK(3, 0, 1) | BLK(2, 1, 1) << 8);
    const unsigned listA = wi == 0 ? (BLK(3, 3, 1) | BLK(0, 0, 1) << 8 | BLK(1, 0, 1) << 16) : wi == 1 ? (BLK(3, 2, 1) | BLK(1, 1, 1) << 8 | BLK(2, 0, 1) << 16) : wi == 2 ? (BLK(3, 1, 1) | BLK(2, 2, 1) << 8 | BLK(0, 1, 1) << 16) : (BLK(3, 0, 1) | BLK(2, 1, 1) << 8 | BLK(2, 3, 1) << 16);
#undef BLK
    const unsigned list = whichm ? listA : listL;
#pragma unroll
    for (int s = 0; s < 3; ++s) {
        const unsigned v = (list >> (8 * s)) & 0xffu; const int mt = v & 3, nt = (v >> 2) & 3;
        if (!(v & 16u)) continue;
        f32x4 acc = {0.f, 0.f, 0.f, 0.f};
        if (nt <= mt) {
#pragma unroll
            for (int kk = 0; kk < 4; ++kk) {
                const pg8::bf16x8 a = *(const LAS pg8::bf16x8*)(Xi + offK(16 * mt + l15, 64 * kk + 16 * g4));
                const pg8::bf16x8 bb = *(const LAS pg8::bf16x8*)(Ki + offK(16 * nt + l15, 64 * kk + 16 * g4));
                acc = __builtin_amdgcn_mfma_f32_16x16x32_bf16(a, bb, acc, 0, 0, 0); } }
        const int cp = 16 * nt + l15; const float gcp = gcs[cp];
#pragma unroll
        for (int e = 0; e < 4; ++e) { const int c = 16 * mt + 4 * g4 + e; const float dec = __expf(gcs[c] - gcp);
            if (whichm == 0) { const float val = (c > cp) ? bts[c] * acc[e] * dec : 0.f; Lg[c * 64 + cp] = val; }
            else { const float val = (c >= cp) ? acc[e] * dec : 0.f; Ag[c * 64 + 32 * (nt >> 1) + 8 * (l15 >> 2) + 4 * (nt & 1) + (l15 & 3)] = (bf16)f2bf(val); } }
    }
}
__device__ __forceinline__ pg8::bf16x8 packB(const f32x4 a, const f32x4 b) { const v4u r = {pk2(a[0], a[1]), pk2(a[2], a[3]), pk2(b[0], b[1]), pk2(b[2], b[3])}; return __builtin_bit_cast(pg8::bf16x8, r); }
__device__ __forceinline__ pg8::bf16x8 frag2(const LAS unsigned char* p1, const LAS unsigned char* p2) {
    const v2u a = *(const LAS v2u*)p1, b = *(const LAS v2u*)p2; const v4u r = {a.x, a.y, b.x, b.y}; return __builtin_bit_cast(pg8::bf16x8, r); }
__device__ __forceinline__ void dn_prep_B4(Frame& F, int base) {
    const int lane = F.lane, w = F.wave, it4 = w >> 1, p = w & 1, l15 = lane & 15, g4 = lane >> 4;
    const int item = base + it4;
    LAS float* Ls = (LAS float*)(F.lds + RING_OFF + it4 * 24576);
    LAS unsigned char* Tl = F.lds + RING_OFF + it4 * 24576 + 16384;
    { const float* Lg = F.LT + (size_t)item * 4096 + p * 2048;
#pragma unroll
      for (int i = 0; i < 8; ++i) { const f32x4 v = ((const GAS f32x4*)Lg)[i * 64 + lane]; *(LAS f32x4*)(Ls + p * 2048 + (i * 64 + lane) * 4) = v; } }
    asm volatile("s_waitcnt vmcnt(0) lgkmcnt(0)" ::: "memory");
    const int rb0 = 32 * p, rb = rb0 + 16 * (g4 & 1), q4 = l15 >> 2, pq = l15 & 3;
    {
        float Td[16];
#pragma unroll
        for (int i = 0; i < 16; ++i) {
            float a0 = 0.f, a1 = 0.f;
            const LAS float* Lr = Ls + (rb + i) * 64 + rb;
#pragma unroll
            for (int q = 0; q < 4; ++q) if (4 * q < i) { const f32x4 lv = *(const LAS f32x4*)(Lr + 4 * q);
#pragma unroll
                for (int e = 0; e < 4; ++e) if (4 * q + e < i) { if (e & 1) a1 += lv[e] * Td[4 * q + e]; else a0 += lv[e] * Td[4 * q + e]; } }
            Td[i] = ((l15 == i) ? 1.f : 0.f) - (a0 + a1);
        }
        if (g4 < 2) {
#pragma unroll
            for (int j = 0; j < 16; ++j) *(LAS bf16*)(Tl + (rb + j) * 128 + (rb + l15) * 2) = (bf16)f2bf(Td[j]);
            *(LAS v4u*)(Tl + (rb0 + (lane >> 1)) * 128 + (rb0 + 16) * 2 + (lane & 1) * 16) = (v4u){0u, 0u, 0u, 0u};
        }
        *(LAS v4u*)(Tl + (16 * p + (lane >> 2)) * 128 + 64 + (lane & 3) * 16) = (v4u){0u, 0u, 0u, 0u};
    }
    asm volatile("s_waitcnt lgkmcnt(0)" ::: "memory");
    {
        const int gk = g4 & 1; const pg8::bf16x8 zf = {0, 0, 0, 0, 0, 0, 0, 0};
        const LAS float* lr = Ls + (rb0 + 16 + l15) * 64 + rb0 + 8 * gk; const f32x4 x0 = *(const LAS f32x4*)lr, x1 = *(const LAS f32x4*)(lr + 4);
        const v4i16_t t1 = vtr(Tl + (rb0 + 8 * gk + q4) * 128 + (rb0 + 4 * pq) * 2), t2 = vtr(Tl + (rb0 + 8 * gk + 4 + q4) * 128 + (rb0 + 4 * pq) * 2);
        pg8::bf16x8 af = packB(x0, x1), bfr = {t1[0], t1[1], t1[2], t1[3], t2[0], t2[1], t2[2], t2[3]};
        if (g4 >= 2) { af = zf; bfr = zf; }
        const f32x4 X = __builtin_amdgcn_mfma_f32_16x16x32_bf16(af, bfr, (f32x4){0.f, 0.f, 0.f, 0.f}, 0, 0, 0);
        const v2u alo = *(const LAS v2u*)(Tl + (rb0 + 16 + l15) * 128 + (rb0 + 16) * 2 + 8 * g4);
        const v4u a4 = {alo.x, alo.y, 0u, 0u};
        const f32x4 R = __builtin_amdgcn_mfma_f32_16x16x32_bf16(__builtin_bit_cast(pg8::bf16x8, a4), packB(X, (f32x4){0.f, 0.f, 0.f, 0.f}), (f32x4){0.f, 0.f, 0.f, 0.f}, 0, 0, 0);
#pragma unroll
        for (int e = 0; e < 4; ++e) *(LAS bf16*)(Tl + (rb0 + 16 + 4 * g4 + e) * 128 + (rb0 + l15) * 2) = (bf16)f2bf(-R[e]);
    }
    asm volatile("s_waitcnt lgkmcnt(0)" ::: "memory");
    __syncthreads();
    {
        f32x4 X[2][2];
#pragma unroll
        for (int mt = 0; mt < 2; ++mt) { const LAS float* lr = Ls + (32 + 16 * mt + l15) * 64 + 8 * g4; const f32x4 x0 = *(const LAS f32x4*)lr, x1 = *(const LAS f32x4*)(lr + 4);
            const pg8::bf16x8 af = packB(x0, x1);
#pragma unroll
            for (int nt = 0; nt < 2; ++nt) {
                const v4i16_t t1 = vtr(Tl + (8 * g4 + q4) * 128 + (16 * nt + 4 * pq) * 2), t2 = vtr(Tl + (8 * g4 + 4 + q4) * 128 + (16 * nt + 4 * pq) * 2);
                const pg8::bf16x8 bfr = {t1[0], t1[1], t1[2], t1[3], t2[0], t2[1], t2[2], t2[3]};
                X[mt][nt] = __builtin_amdgcn_mfma_f32_16x16x32_bf16(af, bfr, (f32x4){0.f, 0.f, 0.f, 0.f}, 0, 0, 0); } }
        const LAS unsigned char* tr22 = Tl + (32 + 16 * p + l15) * 128 + 64;
        const pg8::bf16x8 a22 = frag2(tr22 + 8 * g4, tr22 + 32 + 8 * g4);
#pragma unroll
        for (int nt = 0; nt < 2; ++nt) { const f32x4 R = __builtin_amdgcn_mfma_f32_16x16x32_bf16(a22, packB(X[0][nt], X[1][nt]), (f32x4){0.f, 0.f, 0.f, 0.f}, 0, 0, 0);
#pragma unroll
            for (int e = 0; e < 4; ++e) *(LAS bf16*)(Tl + (32 + 16 * p + 4 * g4 + e) * 128 + (16 * nt + l15) * 2) = (bf16)f2bf(-R[e]); }
    }
    asm volatile("s_waitcnt lgkmcnt(0)" ::: "memory");
    __syncthreads();
    { unsigned char* Tg = (unsigned char*)F.LT + (size_t)item * 16384;
#pragma unroll
      for (int i = 0; i < 4; ++i) { const int id = (p * 4 + i) * 64 + lane, row = id >> 3, dc = id & 7;
          const LAS unsigned char* s = Tl + row * 128 + (32 * (dc >> 2) + 4 * (dc & 3)) * 2; const v2u lo = *(const LAS v2u*)s, hi = *(const LAS v2u*)(s + 32);
          *(GAS v4u*)(Tg + id * 16) = (v4u){lo.x, lo.y, hi.x, hi.y}; } }
}


__device__ __forceinline__ void dn_scan2(Frame& F, int unit) {
    const int lane = F.lane, w = F.wave, l15 = lane & 15, g4 = lane >> 4, trq = l15 >> 2, trp = l15 & 3;
    const int half = unit & 1, h = (unit >> 1) & 3, b = unit >> 3;
    LAS unsigned char* L = F.lds + RING_OFF;
    constexpr int BUFS = 58368, O_K = 0, O_Q = 16384, O_T = 32768, O_A = 40960, O_V = 49152, O_CS = 57344, O_O = 2 * BUFS;
    const int lw = w - 4;
#define DN_GLDS(gp, ldsoff) __builtin_amdgcn_global_load_lds((const unsigned*)(gp), (LAS unsigned*)(ldsoff), 16, 0, 0)
#define DN_FSWZ(r) ((((r) & 3) << 2) | (((r) >> 2) & 3))
#define DN_LOAD2(m, Bn) do { const int cgm = b * 32 + (m); const size_t rowm = (size_t)cgm * 64; const int itm = cgm * 4 + h; \
        _Pragma("unroll") for (int i = 0; i < 4; ++i) { const int p = lw * 4 + i, kr = 4 * p + (lane >> 4), kc = (lane & 15) ^ DN_FSWZ(kr & 15); \
            const bf16* pk = F.PROJ + (rowm + kr) * NPROJ + h * 128 + kc * 8; DN_GLDS(pk + C_DNK, (Bn) + O_K + p * 1024); DN_GLDS(pk + C_DNQ, (Bn) + O_Q + p * 1024); } \
        _Pragma("unroll") for (int i = 0; i < 2; ++i) { const int p = lw * 2 + i, tr_ = 8 * p + (lane >> 3), tc = (lane & 7) ^ ((tr_ >> 1) & 7); \
            DN_GLDS((const bf16*)((const unsigned char*)F.LT + (size_t)itm * 16384) + tr_ * 64 + tc * 8, (Bn) + O_T + p * 1024); \
            DN_GLDS(F.AIMG + (size_t)itm * 4096 + tr_ * 64 + tc * 8, (Bn) + O_A + p * 1024); \
            DN_GLDS(F.PROJ + (rowm + tr_) * NPROJ + C_DNV + h * 128 + 64 * half + (lane & 7) * 8, (Bn) + O_V + p * 1024); } \
        if (lw == 0) DN_GLDS(F.CS + (size_t)itm * 256 + lane * 4, (Bn) + O_CS); } while (0)
#define DN_STORE_O(m, Ob) do { const size_t rowm = (size_t)(b * 32 + (m)) * 64; \
        _Pragma("unroll") for (int i = 0; i < 2; ++i) { const int id = lw * 128 + i * 64 + lane, rr = id >> 3, cc = id & 7; \
            const v4u ov = *(const LAS v4u*)((Ob) + rr * 128 + cc * 16); *(GAS v4u*)(F.PROJ + (rowm + rr) * NPROJ + C_DNV + h * 128 + 64 * half + cc * 8) = ov; } } while (0)
    f32x4 S[8];
#pragma unroll
    for (int kt = 0; kt < 8; ++kt) S[kt] = (f32x4){0.f, 0.f, 0.f, 0.f};
    if (w >= 4) DN_LOAD2(0, L);
    if (w < 4) __builtin_amdgcn_s_setprio(2);
#pragma unroll 2
    for (int n = 0; n < 32; ++n) {
        asm volatile("s_waitcnt vmcnt(0)" ::: "memory");
        __syncthreads();
        const int cur = n & 1; LAS unsigned char* B = L + cur * BUFS;
        if (w >= 4) {
            if (n > 0) DN_STORE_O(n - 1, L + O_O + (cur ^ 1) * 8192);
            if (n < 31) DN_LOAD2(n + 1, L + (cur ^ 1) * BUFS);
        } else {
            const LAS float* cs = (const LAS float*)(B + O_CS);
            pg8::bf16x8 Sb[4];
#pragma unroll
            for (int kk = 0; kk < 4; ++kk) Sb[kk] = packB(S[2 * kk], S[2 * kk + 1]);
            pg8::bf16x8 Rb[2];
            {   f32x4 KS[4];
#pragma unroll
                for (int mt = 0; mt < 4; ++mt) { KS[mt] = (f32x4){0.f, 0.f, 0.f, 0.f}; const int rb = 16 * mt + l15;
#pragma unroll
                    for (int kk = 0; kk < 4; ++kk)
                        KS[mt] = __builtin_amdgcn_mfma_f32_16x16x32_bf16(*(const LAS pg8::bf16x8*)(B + O_K + rb * 256 + (((4 * kk + g4) ^ DN_FSWZ(l15)) << 4)), Sb[kk], KS[mt], 0, 0, 0); }
#pragma unroll
                for (int mt = 0; mt < 4; ++mt) { const f32x4 eg = *(const LAS f32x4*)(cs + 16 * mt + 4 * g4), bt = *(const LAS f32x4*)(cs + 64 + 16 * mt + 4 * g4);
#pragma unroll
                    for (int e = 0; e < 4; ++e) { const float vf = bf2f(*(const LAS bf16*)(B + O_V + (16 * mt + 4 * g4 + e) * 128 + (16 * w + l15) * 2)); KS[mt][e] = bt[e] * (vf - eg[e] * KS[mt][e]); } }
                Rb[0] = packB(KS[0], KS[1]); Rb[1] = packB(KS[2], KS[3]); }
            pg8::bf16x8 Vb[2], Db[2];
            {   f32x4 VN[4];
#pragma unroll
                for (int mt = 0; mt < 4; ++mt) { VN[mt] = (f32x4){0.f, 0.f, 0.f, 0.f}; const int rb = 16 * mt + l15;
#pragma unroll
                    for (int k2 = 0; k2 < 2; ++k2) if (k2 <= (mt >> 1))
                        VN[mt] = __builtin_amdgcn_mfma_f32_16x16x32_bf16(*(const LAS pg8::bf16x8*)(B + O_T + rb * 128 + (((4 * k2 + g4) ^ ((rb >> 1) & 7)) << 4)), Rb[k2], VN[mt], 0, 0, 0); }
                Vb[0] = packB(VN[0], VN[1]); Vb[1] = packB(VN[2], VN[3]);
                const f32x4 d0 = *(const LAS f32x4*)(cs + 128 + 4 * g4), d1 = *(const LAS f32x4*)(cs + 128 + 16 + 4 * g4), d2 = *(const LAS f32x4*)(cs + 128 + 32 + 4 * g4), d3 = *(const LAS f32x4*)(cs + 128 + 48 + 4 * g4);
                Db[0] = packB(VN[0] * d0, VN[1] * d1); Db[1] = packB(VN[2] * d2, VN[3] * d3); }
            LAS unsigned char* Ob = L + O_O + cur * 8192;
#pragma unroll
            for (int mt = 0; mt < 4; ++mt) { f32x4 qs = {0.f, 0.f, 0.f, 0.f}; const int rb = 16 * mt + l15;
#pragma unroll
                for (int kk = 0; kk < 4; ++kk)
                    qs = __builtin_amdgcn_mfma_f32_16x16x32_bf16(*(const LAS pg8::bf16x8*)(B + O_Q + rb * 256 + (((4 * kk + g4) ^ DN_FSWZ(l15)) << 4)), Sb[kk], qs, 0, 0, 0);
                const f32x4 eg = *(const LAS f32x4*)(cs + 16 * mt + 4 * g4);
                f32x4 oc = eg * qs;
#pragma unroll
                for (int k2 = 0; k2 < 2; ++k2) if (k2 <= (mt >> 1))
                    oc = __builtin_amdgcn_mfma_f32_16x16x32_bf16(*(const LAS pg8::bf16x8*)(B + O_A + rb * 128 + (((4 * k2 + g4) ^ ((rb >> 1) & 7)) << 4)), Vb[k2], oc, 0, 0, 0);
                const unsigned p01 = pk2(oc[0], oc[1]), p23 = pk2(oc[2], oc[3]);
                LAS unsigned char* op = Ob + (16 * mt + 4 * g4) * 128 + (16 * w + l15) * 2;
                *(LAS bf16*)(op) = (bf16)(p01 & 0xffffu); *(LAS bf16*)(op + 128) = (bf16)(p01 >> 16); *(LAS bf16*)(op + 256) = (bf16)(p23 & 0xffffu); *(LAS bf16*)(op + 384) = (bf16)(p23 >> 16); }
            const float EGL = cs[192];
            if (n < 31)
#pragma unroll
            for (int kt = 0; kt < 8; ++kt) { S[kt] = S[kt] * EGL;
#pragma unroll
                for (int k2 = 0; k2 < 2; ++k2) { const int c1 = 32 * k2 + 4 * g4 + trq, c2 = c1 + 16;
                    const v4i16_t t1 = vtr(B + O_K + c1 * 256 + (((4 * (kt >> 1) + trp) ^ DN_FSWZ(c1 & 15)) << 4) + 8 * (kt & 1)), t2 = vtr(B + O_K + c2 * 256 + (((4 * (kt >> 1) + trp) ^ DN_FSWZ(c2 & 15)) << 4) + 8 * (kt & 1));
                    const pg8::bf16x8 af = {t1[0], t1[1], t1[2], t1[3], t2[0], t2[1], t2[2], t2[3]};
                    S[kt] = __builtin_amdgcn_mfma_f32_16x16x32_bf16(af, Db[k2], S[kt], 0, 0, 0); } }
        }
    }
    __builtin_amdgcn_s_setprio(0);
    __syncthreads();
    if (w >= 4) DN_STORE_O(31, L + O_O + 8192);
#undef DN_LOAD2
#undef DN_STORE_O
#undef DN_GLDS
#undef DN_FSWZ
}
__device__ __forceinline__ void p2_post(Frame& F, int widx, int nwv) {
    const int lane = F.lane, h = lane >> 4, ch = lane & 15;
    const f32x4 nw0 = *(const GAS f32x4*)(F.dn_norm_w + ch * 8), nw1 = *(const GAS f32x4*)(F.dn_norm_w + ch * 8 + 4);
    const float nwv_[8] = {nw0.x, nw0.y, nw0.z, nw0.w, nw1.x, nw1.y, nw1.z, nw1.w};
    float l0, l1, l2; v4u a, bq, cq, z, zdn, od;
#define POST_LOAD(row_) do { const bf16* bs_ = F.PROJ + (size_t)(row_) * NPROJ; const float* lp_ = F.LSE + (size_t)(row_) * 12 + h; l0 = lp_[0]; l1 = lp_[4]; l2 = lp_[8]; \
        a = *(const GAS v4u*)(bs_ + C_SQ + h * 128 + ch * 8); bq = *(const GAS v4u*)(bs_ + C_SQ + 512 + h * 128 + ch * 8); cq = *(const GAS v4u*)(bs_ + C_SQ + 1024 + h * 128 + ch * 8); \
        z = *(const GAS v4u*)(bs_ + C_SZ + h * 128 + ch * 8); zdn = *(const GAS v4u*)(bs_ + C_DNZ + h * 128 + ch * 8); od = *(const GAS v4u*)(bs_ + C_DNV + h * 128 + ch * 8); } while (0)
    if (widx < M) POST_LOAD(widx);
    for (int row = widx; row < M; row += nwv) {
        const float mx = fmaxf(l0, fmaxf(l1, l2));
        float w0 = __builtin_amdgcn_exp2f(l0 - mx), w1 = __builtin_amdgcn_exp2f(l1 - mx), w2 = __builtin_amdgcn_exp2f(l2 - mx);
        const float inv = __builtin_amdgcn_rcpf(w0 + w1 + w2); w0 *= inv; w1 *= inv; w2 *= inv;
        const unsigned aa[4] = {a.x, a.y, a.z, a.w}, bb[4] = {bq.x, bq.y, bq.z, bq.w}, cc[4] = {cq.x, cq.y, cq.z, cq.w}, zz[4] = {z.x, z.y, z.z, z.w};
        const unsigned dd[4] = {od.x, od.y, od.z, od.w}, zq[4] = {zdn.x, zdn.y, zdn.z, zdn.w};
        if (row + nwv < M) POST_LOAD(row + nwv);
        unsigned oo[4];
#pragma unroll
        for (int e = 0; e < 4; ++e) {
            const float lo = (w0 * bf_lo(aa[e]) + w1 * bf_lo(bb[e]) + w2 * bf_lo(cc[e])) * siluf_(bf_lo(zz[e]));
            const float hi = (w0 * bf_hi(aa[e]) + w1 * bf_hi(bb[e]) + w2 * bf_hi(cc[e])) * siluf_(bf_hi(zz[e]));
            oo[e] = pk2(lo, hi); }
        float ss = 0.f;
#pragma unroll
        for (int e = 0; e < 4; ++e) { const float x0 = bf_lo(dd[e]), x1 = bf_hi(dd[e]); ss += x0 * x0 + x1 * x1; }
        ss = row16_sum(ss);
        const float rstd = __builtin_amdgcn_rsqf(ss * (1.f / 128.f) + EPS);
        unsigned on[4];
#pragma unroll
        for (int e = 0; e < 4; ++e) on[e] = pk2((bf_lo(dd[e]) * rstd) * nwv_[2 * e] * siluf_(bf_lo(zq[e])), (bf_hi(dd[e]) * rstd) * nwv_[2 * e + 1] * siluf_(bf_hi(zq[e])));
        *(GAS v4u*)(F.OSWA + (size_t)row * 512 + h * 128 + ch * 8) = (v4u){oo[0], oo[1], oo[2], oo[3]};
        *(GAS v4u*)(F.ODN + (size_t)row * 512 + h * 128 + ch * 8) = (v4u){on[0], on[1], on[2], on[3]};
    }
#undef POST_LOAD
}

struct Args { const float* in[12]; float* out; unsigned char* ws; int ph_lo, ph_hi; };
__global__ void __launch_bounds__(NWAVES * 64, 2) fwd_kernel(Args args) {
    extern __shared__ __attribute__((aligned(16))) unsigned char lds[];
    Frame F;
    F.lds = (LAS unsigned char*)lds;
    F.MISC = (volatile LAS unsigned*)(F.lds + MISC_OFF);
    F.tid = threadIdx.x; F.lane = F.tid & 63; F.wave = __builtin_amdgcn_readfirstlane(F.tid >> 6);
    F.G = gridDim.x; { const int bx = blockIdx.x; F.vcu = (F.G % 8 == 0) ? (bx % 8) * (F.G / 8) + bx / 8 : bx; }
    unsigned char* ws = args.ws;
    F.ctl = (gu32*)(ws + WS_CTL);
    F.x = args.in[0]; F.norm_w = args.in[1]; F.w_in = args.in[2]; F.conv_w = args.in[3]; F.a_log = args.in[4]; F.dt_bias = args.in[5]; F.dn_norm_w = args.in[6];
    F.q_norm_w = args.in[7]; F.k_norm_w = args.in[8]; F.w_bdn = args.in[9]; F.w_bswa = args.in[10]; F.w_out = args.in[11]; F.out = args.out;
    F.WinT = (bf16*)(ws + WS_WIN); F.WgT = (bf16*)(ws + WS_WG); F.WdnT = (bf16*)(ws + WS_WDN); F.WswaT = (bf16*)(ws + WS_WSWA); F.WoutT = (bf16*)(ws + WS_WOUT);
    F.H = (bf16*)args.out; F.PROJ = (bf16*)(ws + WS_PROJ); F.BG = (float*)(ws + WS_BG); F.ROPE = (float*)(ws + WS_ROPE); F.LSE = (float*)(ws + WS_LSE); F.ODN = (bf16*)((unsigned char*)args.out + OUT_ODN); F.OSWA = (bf16*)((unsigned char*)args.out + OUT_OSWA);
    F.LT = (float*)((unsigned char*)args.out + OUT_LT); F.CS = (float*)((unsigned char*)args.out + OUT_CS); F.AIMG = (bf16*)((unsigned char*)args.out + OUT_A); F.HALO = (bf16*)((unsigned char*)args.out + OUT_HALO);
    for (int u = F.tid; u < (LDS_BYTES - LDSCTL_OFF) / 4; u += NWAVES * 64) ((LAS unsigned*)(F.lds + LDSCTL_OFF))[u] = 0u;
    __syncthreads();
    XcdBarrier bar = xcd_barrier_post((unsigned*)(F.ctl + CW_BAR), F.MISC + 8);
    const int lo = args.ph_lo, hi = args.ph_hi;
#define IN(k) (lo <= (k) && (k) < hi)
#define BOTH(k) (IN(k) && IN((k) + 1))
#define GRID_BAR() xcd_barrier(bar)

    if (IN(0)) { p0_prologue(F); if (BOTH(0)) GRID_BAR(); }

    if (IN(1)) {
        pg8::Gemm g{F.H, F.WinT, M, NPROJ, D, D, D}; pg8::StaticOrder S; S.init(M, NPROJ, F.G, (int)blockIdx.x);
        pg8::EpiBf<0> E{F.PROJ, nullptr, nullptr, NPROJ, F.HALO, F.q_norm_w, F.k_norm_w, F.ROPE, (LAS float*)(F.lds + 131072)};
        pg8::gemm_phase<pg8::EpiBf<0>, pg8::StaticOrder, true, true>(F.lds + RING_OFF, g, S, E);
        if (BOTH(1)) GRID_BAR();
    }
    if (IN(2)) {
        { const int base = F.vcu * 4;
            v4u raw[11]; f32x4 cw[4][2]; float gv = 0.f, bt = 0.f;
            prepA_load(F, base, raw, cw, gv, bt);
            asm volatile("s_waitcnt vmcnt(0)" ::: "memory");
            __syncthreads();
            prepA_conv(F, base, raw, cw, gv, bt, 0);
            prepA_load(F, base + 1, raw, cw, gv, bt);
#pragma unroll 1
            for (int j = 0; j < 4; ++j) {
                asm volatile("s_waitcnt vmcnt(0)" ::: "memory");
                __syncthreads();
                if (j < 3) { prepA_conv(F, base + j + 1, raw, cw, gv, bt, (j + 1) & 1);
                    if (j < 2) prepA_load(F, base + j + 2, raw, cw, gv, bt); }
                prepA_mfma(F, base + j, j & 1);
            }
            asm volatile("s_waitcnt vmcnt(0)" ::: "memory");
            __syncthreads();
            dn_prep_B4(F, base);
            asm volatile("s_waitcnt vmcnt(0)" ::: "memory");
            __syncthreads();
        }
        if (BOTH(2)) GRID_BAR();
    }
    if (IN(3)) {
        if (F.vcu < 64) dn_scan2(F, F.vcu);
        else { p2_attn_run(F, F.vcu - 64); __syncthreads();
            tr_run(F, TR_I_IN, TR_NITEMS, (LAS float*)(F.lds + RING_OFF + F.wave * 8704), (F.vcu - 64) * NWAVES + F.wave, (F.G - 64) * NWAVES); }
        if (BOTH(3)) GRID_BAR();
    }
    if (IN(4)) { p2_post(F, F.vcu * NWAVES + F.wave, F.G * NWAVES); if (BOTH(4)) GRID_BAR(); }
    if (IN(5)) {
        struct P3Sched { int pm, pn; bool ok; const bf16 *H, *WgT, *WdnT, *WswaT, *ODN, *OSWA; bf16* PJ;
            __device__ __forceinline__ bool next(int i, pg8::UnitD& u) const {
                if (!ok || i >= 4) return false;
                u.pm = pm; u.pn = pn;
                const size_t prow = (size_t)pm * 256; bf16* scr1 = PJ + PJ_SCR1 / 2; bf16* scr2 = PJ + PJ_SCR2 / 2; bf16* scr3 = PJ + PJ_SCR3 / 2; bf16* mrg = PJ + PJ_MERGED / 2;
                if (i == 0)      { u.A = (const char*)(H + prow * D); u.lda2 = D * 2; u.B = (const char*)(WgT + (size_t)pn * 256 * D); u.ldb2 = D * 2; u.nt = 16; u.mode = 1; u.O = scr1; u.S1 = nullptr; u.S2 = nullptr; }
                else if (i == 1) { u.A = (const char*)(ODN + prow * 512); u.lda2 = 512 * 2; u.B = (const char*)(WdnT + (size_t)pn * 256 * 512); u.ldb2 = 512 * 2; u.nt = 8; u.mode = 2; u.O = scr2; u.S1 = scr1; u.S2 = nullptr; }
                else if (i == 2) { u.A = (const char*)(H + prow * D); u.lda2 = D * 2; u.B = (const char*)(WgT + (size_t)(1024 + pn * 256) * D); u.ldb2 = D * 2; u.nt = 16; u.mode = 1; u.O = scr3; u.S1 = nullptr; u.S2 = nullptr; }
                else             { u.A = (const char*)(OSWA + prow * 512); u.lda2 = 512 * 2; u.B = (const char*)(WswaT + (size_t)pn * 256 * 512); u.ldb2 = 512 * 2; u.nt = 8; u.mode = 3; u.O = mrg; u.S1 = scr3; u.S2 = scr2; }
                return true; } };
        pg8::StaticOrder S0; S0.init(M, D, F.G, (int)blockIdx.x); pg8::Unit u0; const bool ok = S0.next(0, u0);
        P3Sched S{u0.pm, u0.pn, ok, F.H, F.WgT, F.WdnT, F.WswaT, F.ODN, F.OSWA, F.PROJ};
        pg8::gemm_stream<P3Sched, true>(F.lds + RING_OFF, S, D);
        if (BOTH(5)) GRID_BAR();
    }
    if (IN(6)) {
        pg8::Gemm g{F.PROJ + PJ_MERGED / 2, F.WoutT, M, D, D, D, D}; pg8::StaticOrder S; S.init(M, D, F.G, (int)blockIdx.x);
        pg8::EpiRes E{F.x, F.out, D};
        pg8::gemm_phase<pg8::EpiRes, pg8::StaticOrder, false, true>(F.lds + RING_OFF, g, S, E);
    }
#undef IN
#undef BOTH
#undef GRID_BAR
}

#ifndef N_LAUNCHES
#define N_LAUNCHES 1
#endif
extern "C" void kernel_launch(void* const* d_in, const int* in_sizes, int n_in, void* d_out, int out_size, void* d_ws, size_t ws_size, hipStream_t stream) {
    static int grid = 0;
    if (grid == 0) {
        if (n_in != 12 || in_sizes[0] != M * D || out_size != M * D || ws_size < WS_END) { fprintf(stderr, "kernel_launch: unexpected shapes (n_in %d, in0 %d, out %d, ws %zu); nothing launched\n", n_in, n_in > 0 ? in_sizes[0] : -1, out_size, ws_size); grid = -1; return; }
        int dev = 0, cus = 0, per_cu = 0;
        if (hipGetDevice(&dev) != hipSuccess || hipDeviceGetAttribute(&cus, hipDeviceAttributeMultiprocessorCount, dev) != hipSuccess) { grid = -1; return; }
        if (hipFuncSetAttribute((const void*)fwd_kernel, hipFuncAttributeMaxDynamicSharedMemorySize, LDS_BYTES) != hipSuccess) { fprintf(stderr, "kernel_launch: hipFuncSetAttribute failed\n"); grid = -1; return; }
        if (hipOccupancyMaxActiveBlocksPerMultiprocessor(&per_cu, (const void*)fwd_kernel, NWAVES * 64, LDS_BYTES) != hipSuccess || per_cu < 1) { fprintf(stderr, "kernel_launch: occupancy query says %d blocks per CU; nothing launched\n", per_cu); (void)hipGetLastError(); grid = -1; return; }
        if (cus != 256) { fprintf(stderr, "kernel_launch: built for a 256-CU device (got %d); nothing launched\n", cus); grid = -1; return; }
        grid = cus;
    }
    if (grid < 0) return;
    (void)hipMemsetAsync((char*)d_ws + WS_CTL, 0, CTL_ZERO_BYTES, stream);
    Args a{};
    for (int i = 0; i < 12; ++i) a.in[i] = (const float*)d_in[i];
    a.out = (float*)d_out; a.ws = (unsigned char*)d_ws;
    constexpr int NPH = 7;
#if N_LAUNCHES == 1
    a.ph_lo = 0; a.ph_hi = NPH;
    hipLaunchKernelGGL(fwd_kernel, dim3(grid), dim3(NWAVES * 64), LDS_BYTES, stream, a);
#else
    for (int p = 0; p < NPH; ++p) { a.ph_lo = p; a.ph_hi = p + 1; hipLaunchKernelGGL(fwd_kernel, dim3(grid), dim3(NWAVES * 64), LDS_BYTES, stream, a); }
#endif
}
```
